# Optimizing an MI355X kernel written in HIP

```python
import jax, jax.numpy as jnp
from jax import lax
import numpy as np

D_MODEL = 2048
BATCH = 8
SEQ = 4096
DEPTH = 4
DEC_BATCH = 8
DEC_SEQ = 32
PAST_LEN = 1024

CHUNK = 64
HEAD_DIM = 128
H_A = 8
H_A_KV = 2
WINDOW = 128
WIN_CHUNKS = WINDOW // CHUNK
H_B = 4
BAND_CHUNKS = 8
BAND_ROWS = BAND_CHUNKS * CHUNK
REL_CLIP = 128
H_M = 4
N_MEM = 256
MIX_WIDTH = (H_A + H_B + H_M) * HEAD_DIM
IN_COLS = (H_A + 2 * H_A_KV + 3 * H_B + H_M) * HEAD_DIM
ROT_DIM = HEAD_DIM // 4
ROPE_THETA = 500000.0
D_FF = ((8 * D_MODEL // 3 + 127) // 128) * 128
EPS = 1e-6

kernel_name = 'hybrid_streaming_encoder_step'


def rms_norm(x, g):
    xf = x.astype(jnp.float32)
    y = xf * lax.rsqrt(jnp.mean(xf * xf, axis=-1, keepdims=True) + EPS)
    return (y * g.astype(jnp.float32)).astype(x.dtype)


def swiglu(h, w_i, w_o):
    gate, up = jnp.split(h @ w_i, 2, axis=-1)
    return (jax.nn.silu(gate) * up) @ w_o


def rope_partial(x, pos):
    half = ROT_DIM // 2
    inv_freq = ROPE_THETA ** (-jnp.arange(half, dtype=jnp.float32) / half)
    ang = pos.astype(jnp.float32)[:, None] * inv_freq[None, :]
    cos = jnp.cos(ang)[None, :, None, :]
    sin = jnp.sin(ang)[None, :, None, :]
    xf = x.astype(jnp.float32)
    x1, x2, rest = xf[..., :half], xf[..., half:ROT_DIM], xf[..., ROT_DIM:]
    out = jnp.concatenate([x1 * cos - x2 * sin, x2 * cos + x1 * sin, rest], axis=-1)
    return out.astype(x.dtype)


def rel_bias_matrix(table):
    band = BAND_ROWS + CHUNK
    i = jnp.arange(CHUNK)[:, None]
    j = jnp.arange(band)[None, :]
    dist = BAND_ROWS + i - j
    idx = jnp.clip(dist, -REL_CLIP, REL_CLIP) + REL_CLIP
    return table[:, idx].astype(jnp.float32)[:, None]


def chunk_band_attention(q, k, v, k_past, v_past, n_past_chunks, sinks, bias):
    b, t, hq, d = q.shape
    hk = k.shape[2]
    g = hq // hk
    p_rows = n_past_chunks * CHUNK
    lp = k_past.shape[1]
    n_chunks = -(-t // CHUNK)
    tp = n_chunks * CHUNK
    band = p_rows + CHUNK

    def pad_rows(x_past, x_new):
        zl = jnp.zeros((b, p_rows - lp, hk, d), x_new.dtype)
        zr = jnp.zeros((b, tp - t, hk, d), x_new.dtype)
        return jnp.concatenate([zl, x_past.astype(x_new.dtype), x_new, zr], axis=1)

    kk = pad_rows(k_past, k)
    vv = pad_rows(v_past, v)
    idx = jnp.arange(p_rows + tp)
    valid = (idx >= p_rows - lp) & (idx < p_rows + t)
    qq = jnp.pad(q, ((0, 0), (0, tp - t), (0, 0), (0, 0))).reshape(b, n_chunks, CHUNK, hk, g, d)
    qq = jnp.moveaxis(qq, 1, 0)
    scale = d ** -0.5
    if sinks is not None:
        sink = sinks.astype(jnp.float32).reshape(hk, g)[None, :, :, None, None]

    def one_chunk(args):
        c, qb = args
        start = c * CHUNK
        kb = lax.dynamic_slice_in_dim(kk, start, band, axis=1)
        vb = lax.dynamic_slice_in_dim(vv, start, band, axis=1)
        mb = lax.dynamic_slice_in_dim(valid, start, band)
        s = jnp.einsum('bqhgd,bkhd->bhgqk', qb.astype(jnp.float32), kb.astype(jnp.float32)) * scale
        if bias is not None:
            s = s + bias[None]
        s = jnp.where(mb[None, None, None, None, :], s, -jnp.inf)
        if sinks is not None:
            m = jnp.maximum(jnp.max(s, axis=-1, keepdims=True), sink)
            e = jnp.exp(s - m)
            p = e / (jnp.sum(e, axis=-1, keepdims=True) + jnp.exp(sink - m))
        else:
            p = jax.nn.softmax(s, axis=-1)
        return jnp.einsum('bhgqk,bkhd->bqhgd', p.astype(vb.dtype), vb)

    out = lax.map(one_chunk, (jnp.arange(n_chunks), qq))
    out = jnp.moveaxis(out, 0, 1).reshape(b, tp, hq, d)
    return out[:, :t]


def memory_kv(mem, g_norm, w_kv, g_k):
    b, n, _ = mem.shape
    m = rms_norm(mem, g_norm) @ w_kv
    mk, mv = jnp.split(m, 2, axis=-1)
    mk = rms_norm(mk.reshape(b, n, H_M, HEAD_DIM), g_k)
    return mk, mv.reshape(b, n, H_M, HEAD_DIM)


def memory_attention(q, mk, mv):
    s = jnp.einsum('bqhd,bmhd->bhqm', q.astype(jnp.float32), mk.astype(jnp.float32)) * (HEAD_DIM ** -0.5)
    p = jax.nn.softmax(s, axis=-1)
    return jnp.einsum('bhqm,bmhd->bqhd', p.astype(mv.dtype), mv.astype(q.dtype))


def trunk_layer(x, pos, a_k_past, a_v_past, b_k_past, b_v_past, mem_k, mem_v, lw):
    (g_ff1, w1i, w1o, g_mix, w_in_l, qk_g, sinks, rel_tab, w_out_l, g_ff2, w2i, w2o) = lw
    b, t, _ = x.shape
    x = x + 0.5 * swiglu(rms_norm(x, g_ff1), w1i, w1o)
    h = rms_norm(x, g_mix)
    proj = h @ w_in_l
    sizes = (H_A * HEAD_DIM, H_A_KV * HEAD_DIM, H_A_KV * HEAD_DIM,
             H_B * HEAD_DIM, H_B * HEAD_DIM, H_B * HEAD_DIM)
    points = []
    acc = 0
    for s_ in sizes:
        acc += s_
        points.append(acc)
    qa, ka, va, qb, kb, vb, qm = jnp.split(proj, points, axis=-1)

    def heads(z, n):
        return z.reshape(b, t, n, HEAD_DIM)

    qa = rope_partial(rms_norm(heads(qa, H_A), qk_g[0]), pos)
    ka = rope_partial(rms_norm(heads(ka, H_A_KV), qk_g[1]), pos)
    va = heads(va, H_A_KV)
    qb = rms_norm(heads(qb, H_B), qk_g[2])
    kb = rms_norm(heads(kb, H_B), qk_g[3])
    vb = heads(vb, H_B)
    qm = rms_norm(heads(qm, H_M), qk_g[4])

    o_a = chunk_band_attention(qa, ka, va, a_k_past, a_v_past, WIN_CHUNKS, sinks, None)
    o_b = chunk_band_attention(qb, kb, vb, b_k_past, b_v_past, BAND_CHUNKS, None, rel_bias_matrix(rel_tab))
    o_m = memory_attention(qm, mem_k, mem_v)
    o = jnp.concatenate([o_a.reshape(b, t, -1), o_b.reshape(b, t, -1), o_m.reshape(b, t, -1)], axis=-1)
    x = x + o @ w_out_l
    x = x + 0.5 * swiglu(rms_norm(x, g_ff2), w2i, w2o)
    return x, ka, va, kb, vb


def setup_inputs(seed: int = 0) -> dict:
    key = jax.random.key(seed)
    ks = jax.random.split(key, 32)
    f32 = jnp.float32
    la = min(WINDOW, PAST_LEN)
    lb = min(BAND_ROWS, PAST_LEN)

    def nrm(k, shape, scale=1.0):
        return jax.random.normal(k, shape, f32) * scale

    def gain(k, shape):
        return 1.0 + 0.05 * jax.random.normal(k, shape, f32)

    return {
        'x_prompt': nrm(ks[0], (BATCH, SEQ, D_MODEL)),
        'x_sample': nrm(ks[1], (DEC_BATCH, DEC_SEQ, D_MODEL)),
        'cache_a_k': nrm(ks[2], (DEPTH, DEC_BATCH, la, H_A_KV, HEAD_DIM)),
        'cache_a_v': nrm(ks[3], (DEPTH, DEC_BATCH, la, H_A_KV, HEAD_DIM)),
        'cache_b_k': nrm(ks[4], (DEPTH, DEC_BATCH, lb, H_B, HEAD_DIM)),
        'cache_b_v': nrm(ks[5], (DEPTH, DEC_BATCH, lb, H_B, HEAD_DIM)),
        'cache_mem_k': nrm(ks[6], (DEPTH, DEC_BATCH, N_MEM, H_M, HEAD_DIM)),
        'cache_mem_v': nrm(ks[7], (DEPTH, DEC_BATCH, N_MEM, H_M, HEAD_DIM)),
        'mem_prompt': nrm(ks[8], (BATCH, N_MEM, D_MODEL)),
        'norm_ff1': gain(ks[9], (DEPTH, D_MODEL)),
        'w_ff1_in': nrm(ks[10], (DEPTH, D_MODEL, 2 * D_FF), D_MODEL ** -0.5),
        'w_ff1_out': nrm(ks[11], (DEPTH, D_FF, D_MODEL), D_FF ** -0.5),
        'norm_mix': gain(ks[12], (DEPTH, D_MODEL)),
        'w_in': nrm(ks[13], (DEPTH, D_MODEL, IN_COLS), D_MODEL ** -0.5),
        'qk_gain': gain(ks[14], (DEPTH, 6, HEAD_DIM)),
        'attn_sinks': nrm(ks[15], (DEPTH, H_A), 0.5),
        'rel_bias': nrm(ks[16], (DEPTH, H_B, 2 * REL_CLIP + 1), 0.1),
        'norm_mem': gain(ks[17], (DEPTH, D_MODEL)),
        'w_mem_kv': nrm(ks[18], (DEPTH, D_MODEL, 2 * H_M * HEAD_DIM), D_MODEL ** -0.5),
        'w_out': nrm(ks[19], (DEPTH, MIX_WIDTH, D_MODEL), MIX_WIDTH ** -0.5),
        'norm_ff2': gain(ks[20], (DEPTH, D_MODEL)),
        'w_ff2_in': nrm(ks[21], (DEPTH, D_MODEL, 2 * D_FF), D_MODEL ** -0.5),
        'w_ff2_out': nrm(ks[22], (DEPTH, D_FF, D_MODEL), D_FF ** -0.5),
    }


def reference(x_prompt, x_sample, cache_a_k, cache_a_v, cache_b_k, cache_b_v, cache_mem_k, cache_mem_v,
              mem_prompt, norm_ff1, w_ff1_in, w_ff1_out, norm_mix, w_in, qk_gain, attn_sinks, rel_bias,
              norm_mem, w_mem_kv, w_out, norm_ff2, w_ff2_in, w_ff2_out):
    b_p, t_p, _ = x_prompt.shape
    t_s = x_sample.shape[1]
    pos_p = jnp.arange(t_p, dtype=jnp.int32)
    pos_s = PAST_LEN + jnp.arange(t_s, dtype=jnp.int32)
    keep_a = min(WINDOW, t_p)
    keep_b = min(BAND_ROWS, t_p)
    empty_a = jnp.zeros((b_p, 0, H_A_KV, HEAD_DIM), x_prompt.dtype)
    empty_b = jnp.zeros((b_p, 0, H_B, HEAD_DIM), x_prompt.dtype)
    xp, xs = x_prompt, x_sample
    ak_p, av_p, bk_p, bv_p, mk_p, mv_p = [], [], [], [], [], []
    ak_s, av_s, bk_s, bv_s = [], [], [], []
    for l in range(DEPTH):
        lw = (norm_ff1[l], w_ff1_in[l], w_ff1_out[l], norm_mix[l], w_in[l], qk_gain[l], attn_sinks[l],
              rel_bias[l], w_out[l], norm_ff2[l], w_ff2_in[l], w_ff2_out[l])
        mk, mv = memory_kv(mem_prompt, norm_mem[l], w_mem_kv[l], qk_gain[l, 5])
        xp, ka, va, kb, vb = trunk_layer(xp, pos_p, empty_a, empty_a, empty_b, empty_b, mk, mv, lw)
        ak_p.append(ka[:, t_p - keep_a:])
        av_p.append(va[:, t_p - keep_a:])
        bk_p.append(kb[:, t_p - keep_b:])
        bv_p.append(vb[:, t_p - keep_b:])
        mk_p.append(mk)
        mv_p.append(mv)
        xs, ka, va, kb, vb = trunk_layer(xs, pos_s, cache_a_k[l], cache_a_v[l], cache_b_k[l], cache_b_v[l],
                                         cache_mem_k[l], cache_mem_v[l], lw)
        ak_s.append(ka)
        av_s.append(va)
        bk_s.append(kb)
        bv_s.append(vb)
    return (xp, xs,
            jnp.stack(ak_p), jnp.stack(av_p), jnp.stack(bk_p), jnp.stack(bv_p),
            jnp.stack(mk_p), jnp.stack(mv_p),
            jnp.stack(ak_s), jnp.stack(av_s), jnp.stack(bk_s), jnp.stack(bv_s))
```

```cpp
#include <hip/hip_runtime.h>
#include <cstdio>
#include <cstdint>

__device__ __forceinline__ int lane_id_opaque() { int l; asm volatile("v_mbcnt_lo_u32_b32 %0, -1, 0\n\tv_mbcnt_hi_u32_b32 %0, -1, %0" : "=v"(l)); return l; }
template <int M> __device__ __forceinline__ float swz_xor(float v) { return __int_as_float(__builtin_amdgcn_ds_swizzle(__float_as_int(v), (M << 10) | 0x1f)); }

namespace pg8 {
#define PG8_LAS __attribute__((address_space(3)))
typedef unsigned short bf16_t;
typedef short bf16x8 __attribute__((ext_vector_type(8)));
typedef float f32x4 __attribute__((ext_vector_type(4)));
typedef unsigned u32x4 __attribute__((ext_vector_type(4)));
constexpr int BM = 256, BK = 64, HALF = 128, HTB = HALF * BK * 2  , STAGE_BYTES = 8 * HTB, NXCD = 8, WGM = 8;

__host__ __device__ __forceinline__ int lds_byte(int r, int c) { const int st = (r >> 4) * 2 + (c >> 5), rr = r & 15, cc = c & 31, ob = rr * 64 + cc * 2; return st * 1024 + (ob ^ (((ob >> 9) & 1) << 5)); }
__host__ __device__ __forceinline__ void stage_rc(int b, int& R, int& C) { const int st = b / 1024, sb = b % 1024, swz = sb ^ (((sb >> 9) & 1) << 5); R = (st >> 1) * 16 + swz / 64; C = (st & 1) * 32 + (swz % 64) / 2; }
__host__ __device__ __forceinline__ int perm32(int rho) { const int n = rho >> 4, i = rho & 15; return 8 * (i >> 2) + 4 * n + (i & 3); }

struct Unit { int pm, pn; };
struct Gemm { const bf16_t* A; const bf16_t* Bt; int M, N, K; };

struct StaticOrder {
    int nM, nN, nwg, G, c;
    __host__ __device__ void init(int M, int N, int G_, int c_) { nM = M / BM; nN = N / BM; nwg = nM * nN; G = G_; c = c_; }
    __host__ __device__ bool next(int i, Unit& u) const {
        const long L = (long)i * G + c; if (L >= nwg) return false;
        int wgid = (int)L; { const int q = nwg / NXCD, r = nwg % NXCD, xcd = wgid % NXCD, off = wgid / NXCD; wgid = (xcd < r ? xcd * (q + 1) : r * (q + 1) + (xcd - r) * q) + off; }
        const int nig = WGM * nN, gid = wgid / nig, fm = gid * WGM, gsz = (nM - fm) < WGM ? (nM - fm) : WGM;
        u.pm = fm + ((wgid % nig) % gsz); u.pn = (wgid % nig) / gsz; return true;
    }
    __device__ __forceinline__ void a_ready(const Unit&) const {}
    __device__ __forceinline__ void done(const Unit&) const {}
};

__device__ __forceinline__ unsigned cvt_pk_bf16(float lo, float hi) { unsigned r; asm volatile("v_cvt_pk_bf16_f32 %0, %1, %2" : "=v"(r) : "v"(lo), "v"(hi)); return r; }

template <class Epi, class Sched, bool ALIGN_EPI = false, bool SP2 = false>
__device__ __forceinline__ void gemm_phase(PG8_LAS unsigned char* lds, const Gemm g, const Sched& S, const Epi& E, const int wid) {
    const int lane = lane_id_opaque();
    const int tid = wid * 64 + lane, wr = wid >> 2, wc = wid & 3, fr = lane & 15, fq = lane >> 4;
    const int K = g.K, nt = K / BK;
    unsigned voffA[2], voffB[2];
#pragma unroll
    for (int i = 0; i < 2; ++i) { int R, C; stage_rc(tid * 16 + i * 8192, R, C); const int Rb = Epi::PERM ? ((R & ~31) + perm32(R & 31)) : R;
        voffA[i] = (unsigned)(R * K + C) * 2u; voffB[i] = (unsigned)(Rb * K + C) * 2u; }
    const size_t kstep = (size_t)(BK * 2);
    const size_t hstep = (size_t)HALF * K * 2;
    const size_t tstep = 2 * hstep;
    const unsigned ldsw = (unsigned)wid * 1024u;
    const int aoff = lds_byte(wr * 64 + fr, fq * 8), boff = lds_byte(wc * 32 + fr, fq * 8);
#define PG8_SA(b, h) (((b) * 2 + (h)) * HTB)
#define PG8_SB(b, h) ((4 + (b) * 2 + (h)) * HTB)
#define PG8_STAGE(bufoff, gbase, voff) do { _Pragma("unroll") for (int _i = 0; _i < 2; ++_i) \
        __builtin_amdgcn_global_load_lds((const unsigned*)((const char*)(gbase) + (voff)[_i]), (PG8_LAS unsigned*)(lds + (bufoff) + ldsw + _i * 8192), 16, 0, 0); } while (0)
#define PG8_LDA(dst, b, h) do { _Pragma("unroll") for (int m = 0; m < 4; ++m) _Pragma("unroll") for (int k = 0; k < 2; ++k) dst[m][k] = *(const PG8_LAS bf16x8*)(lds + PG8_SA(b, h) + aoff + m * 2048 + k * 1024); } while (0)
#define PG8_LDB(dst, b, h) do { _Pragma("unroll") for (int n = 0; n < 2; ++n) _Pragma("unroll") for (int k = 0; k < 2; ++k) dst[n][k] = *(const PG8_LAS bf16x8*)(lds + PG8_SB(b, h) + boff + n * 2048 + k * 1024); } while (0)
#define PG8_MMA(ai, bj, At, Bt) do { __builtin_amdgcn_s_setprio(1); _Pragma("unroll") for (int m = 0; m < 4; ++m) _Pragma("unroll") for (int n = 0; n < 2; ++n) _Pragma("unroll") for (int k = 0; k < 2; ++k) \
        acc[ai][bj][m][n] = __builtin_amdgcn_mfma_f32_16x16x32_bf16(Bt[n][k], At[m][k], acc[ai][bj][m][n], 0, 0, 0); __builtin_amdgcn_s_setprio(0); } while (0)
#define PG8_WAIT_V(n) asm volatile("s_waitcnt vmcnt(" #n ")" ::: "memory")
#define PG8_WAIT_L(n) asm volatile("s_waitcnt lgkmcnt(" #n ")" ::: "memory")
#define PG8_BAR __builtin_amdgcn_s_barrier()
#define PG8_SCHED __builtin_amdgcn_sched_barrier(0)
    Unit cur, nxt; int ui = 0;
    if (!S.next(0, cur)) return;
    f32x4 acc[2][2][4][2];
#pragma unroll
    for (int a = 0; a < 2; ++a)
#pragma unroll
        for (int b = 0; b < 2; ++b)
#pragma unroll
            for (int m = 0; m < 4; ++m)
#pragma unroll
                for (int n = 0; n < 2; ++n) acc[a][b][m][n] = (f32x4){0.f, 0.f, 0.f, 0.f};
    bf16x8 At[4][2], B0[2][2], B1[2][2];
    const char* cA = (const char*)g.A + (size_t)cur.pm * tstep; const char* cB = (const char*)g.Bt + (size_t)cur.pn * tstep;
    S.a_ready(cur);
    if constexpr (SP2) {
        PG8_STAGE(PG8_SB(0, 0), cB, voffB); PG8_STAGE(PG8_SB(0, 1), cB + hstep, voffB); PG8_STAGE(PG8_SA(0, 0), cA, voffA); PG8_STAGE(PG8_SA(0, 1), cA + hstep, voffA);
        if (wr == 1) PG8_BAR;
        PG8_WAIT_V(2); PG8_BAR;
        PG8_STAGE(PG8_SB(1, 0), cB + kstep, voffB); PG8_STAGE(PG8_SA(1, 0), cA + kstep, voffA); PG8_STAGE(PG8_SB(1, 1), cB + hstep + kstep, voffB);
        PG8_WAIT_V(6); PG8_BAR;
    } else {
        PG8_STAGE(PG8_SB(0, 0), cB, voffB); PG8_STAGE(PG8_SA(0, 0), cA, voffA); PG8_STAGE(PG8_SB(0, 1), cB + hstep, voffB); PG8_STAGE(PG8_SA(0, 1), cA + hstep, voffA);
        if (wr == 1) PG8_BAR;
        PG8_WAIT_V(4); PG8_BAR;
        PG8_STAGE(PG8_SB(1, 0), cB + kstep, voffB); PG8_STAGE(PG8_SA(1, 0), cA + kstep, voffA); PG8_STAGE(PG8_SB(1, 1), cB + hstep + kstep, voffB);
        PG8_WAIT_V(6); PG8_BAR;
    }
    for (;;) {
        const bool has_next = S.next(ui + 1, nxt);
        const char* nA = has_next ? (const char*)g.A + (size_t)nxt.pm * tstep : cA; const char* nB = has_next ? (const char*)g.Bt + (size_t)nxt.pn * tstep : cB;
        for (int t = 0; t < nt; t += 2) {
            const bool last = (t == nt - 2);
            const char* a1 = cA + (size_t)(t + 1) * kstep;
            const char* a2 = last ? nA : cA + (size_t)(t + 2) * kstep; const char* b2 = last ? nB : cB + (size_t)(t + 2) * kstep;
            const char* a3 = a2 + kstep; const char* b3 = b2 + kstep;
            if (last && has_next) S.a_ready(nxt);
            if constexpr (SP2) {
            PG8_LDB(B0, 0, 0); PG8_LDB(B1, 0, 1); PG8_SCHED; PG8_LDA(At, 0, 0); PG8_STAGE(PG8_SA(1, 1), a1 + hstep, voffA);
            PG8_WAIT_V(8); PG8_WAIT_L(0); PG8_BAR; PG8_MMA(0, 0, At, B0); PG8_MMA(0, 1, At, B1); PG8_BAR; PG8_SCHED;
            PG8_LDA(At, 0, 1); PG8_STAGE(PG8_SB(0, 0), b2, voffB); PG8_STAGE(PG8_SB(0, 1), b2 + hstep, voffB); PG8_STAGE(PG8_SA(0, 0), a2, voffA);
            PG8_WAIT_V(8); PG8_WAIT_L(0); PG8_BAR; PG8_MMA(1, 0, At, B0); PG8_MMA(1, 1, At, B1); PG8_BAR; PG8_SCHED;
            PG8_LDB(B0, 1, 0); PG8_LDB(B1, 1, 1); PG8_SCHED; PG8_LDA(At, 1, 0); PG8_STAGE(PG8_SA(0, 1), a2 + hstep, voffA);
            PG8_WAIT_V(8); PG8_WAIT_L(0); PG8_BAR; PG8_MMA(0, 0, At, B0); PG8_MMA(0, 1, At, B1); PG8_BAR; PG8_SCHED;
            PG8_LDA(At, 1, 1); PG8_STAGE(PG8_SB(1, 0), b3, voffB); PG8_STAGE(PG8_SB(1, 1), b3 + hstep, voffB); PG8_STAGE(PG8_SA(1, 0), a3, voffA);
            PG8_WAIT_V(8); PG8_WAIT_L(0); PG8_BAR; PG8_MMA(1, 0, At, B0); PG8_MMA(1, 1, At, B1); PG8_BAR; PG8_SCHED;
            } else {
            PG8_LDB(B0, 0, 0); PG8_SCHED; PG8_LDA(At, 0, 0); PG8_STAGE(PG8_SA(1, 1), a1 + hstep, voffA);
            PG8_WAIT_L(8); PG8_BAR; PG8_WAIT_L(0); PG8_MMA(0, 0, At, B0); PG8_BAR; PG8_SCHED;
            PG8_LDB(B1, 0, 1); PG8_STAGE(PG8_SB(0, 0), b2, voffB);
            PG8_BAR; PG8_WAIT_L(0); PG8_MMA(0, 1, At, B1); PG8_BAR;
            PG8_LDA(At, 0, 1); PG8_STAGE(PG8_SA(0, 0), a2, voffA);
            PG8_BAR; PG8_WAIT_L(0); PG8_MMA(1, 0, At, B0); PG8_BAR; PG8_SCHED;
            PG8_STAGE(PG8_SB(0, 1), b2 + hstep, voffB);
            PG8_WAIT_V(6); PG8_BAR; PG8_MMA(1, 1, At, B1); PG8_BAR;
            PG8_LDB(B0, 1, 0); PG8_SCHED; PG8_LDA(At, 1, 0); PG8_STAGE(PG8_SA(0, 1), a2 + hstep, voffA);
            PG8_WAIT_L(8); PG8_BAR; PG8_WAIT_L(0); PG8_MMA(0, 0, At, B0); PG8_BAR; PG8_SCHED;
            PG8_LDB(B1, 1, 1); PG8_STAGE(PG8_SB(1, 0), b3, voffB);
            PG8_BAR; PG8_WAIT_L(0); PG8_MMA(0, 1, At, B1); PG8_BAR;
            PG8_LDA(At, 1, 1); PG8_STAGE(PG8_SA(1, 0), a3, voffA);
            PG8_BAR; PG8_WAIT_L(0); PG8_MMA(1, 0, At, B0); PG8_BAR; PG8_SCHED;
            PG8_STAGE(PG8_SB(1, 1), b3 + hstep, voffB);
            PG8_WAIT_V(6); PG8_BAR; PG8_MMA(1, 1, At, B1); PG8_BAR;
            }
        }
        if constexpr (ALIGN_EPI) { if (wr == 0) PG8_BAR; }
        E(acc, cur, wr, wc, fr, fq); S.done(cur);
        if (!has_next) break;
#pragma unroll
        for (int a = 0; a < 2; ++a)
#pragma unroll
            for (int b = 0; b < 2; ++b)
#pragma unroll
                for (int m = 0; m < 4; ++m)
#pragma unroll
                    for (int n = 0; n < 2; ++n) acc[a][b][m][n] = (f32x4){0.f, 0.f, 0.f, 0.f};
        cur = nxt; cA = nA; cB = nB; ++ui;
        if constexpr (ALIGN_EPI) { if (wr == 1) PG8_BAR; }
    }
    PG8_WAIT_V(0);
    if constexpr (!ALIGN_EPI) { if (wr == 0) PG8_BAR; }
    PG8_BAR;
#undef PG8_SA
#undef PG8_SB
#undef PG8_STAGE
#undef PG8_LDA
#undef PG8_LDB
#undef PG8_MMA
#undef PG8_WAIT_V
#undef PG8_WAIT_L
#undef PG8_BAR
#undef PG8_SCHED
}
}

constexpr int DM = 2048, NBATCH = 8, SEQ = 4096, DEPTH = 4, SBATCH = 8, SSEQ = 32, PAST = 1024;
constexpr int HD = 128, NMEM = 256;
constexpr int INC = 3584, DFF = 5504, MIXW = 2048;
constexpr int MP = NBATCH * SEQ, MS = SBATCH * SSEQ, MT = MP + MS;
constexpr int MMEM = NBATCH * NMEM;
constexpr int C_QA = 0, C_KA = 1024, C_VA = 1280, C_QB = 1536, C_KB = 2048, C_VB = 2560, C_QM = 3072;
constexpr float EPS = 1e-6f;
constexpr float LOG2E = 1.4426950408889634f;

constexpr size_t O_YP = 0;
constexpr size_t O_YS = O_YP + (size_t)MP * DM;
constexpr size_t O_AKP = O_YS + (size_t)MS * DM;
constexpr size_t O_AVP = O_AKP + (size_t)DEPTH * NBATCH * 128 * 2 * HD;
constexpr size_t O_BKP = O_AVP + (size_t)DEPTH * NBATCH * 128 * 2 * HD;
constexpr size_t O_BVP = O_BKP + (size_t)DEPTH * NBATCH * 512 * 4 * HD;
constexpr size_t O_MKP = O_BVP + (size_t)DEPTH * NBATCH * 512 * 4 * HD;
constexpr size_t O_MVP = O_MKP + (size_t)DEPTH * NBATCH * NMEM * 4 * HD;
constexpr size_t O_AKS = O_MVP + (size_t)DEPTH * NBATCH * NMEM * 4 * HD;
constexpr size_t O_AVS = O_AKS + (size_t)DEPTH * SBATCH * SSEQ * 2 * HD;
constexpr size_t O_BKS = O_AVS + (size_t)DEPTH * SBATCH * SSEQ * 2 * HD;
constexpr size_t O_BVS = O_BKS + (size_t)DEPTH * SBATCH * SSEQ * 4 * HD;
constexpr size_t O_END = O_BVS + (size_t)DEPTH * SBATCH * SSEQ * 4 * HD;
static_assert(O_END == 96468992, "output size");

constexpr size_t MiB = 1u << 20;
constexpr size_t WS_CTL = 0, CTL_ZERO_BYTES = 1 * MiB;
constexpr size_t SZ_W1A = (size_t)2 * DFF * DM * 2, SZ_W1B = (size_t)DM * DFF * 2, SZ_WIN = (size_t)INC * DM * 2, SZ_WOUT = (size_t)DM * MIXW * 2;
constexpr size_t LW_W1A = 0, LW_W1B = LW_W1A + SZ_W1A, LW_WIN = LW_W1B + SZ_W1B, LW_WOUT = LW_WIN + SZ_WIN, LW_W2A = LW_WOUT + SZ_WOUT, LW_W2B = LW_W2A + SZ_W1A, LW_END = LW_W2B + SZ_W1B;
constexpr size_t WS_W = 2 * MiB;
constexpr size_t WS_WMEM = WS_W + DEPTH * LW_END;
constexpr size_t WS_H = WS_WMEM + (size_t)DEPTH * 1024 * DM * 2;
constexpr size_t WS_AMEM = WS_H + (size_t)MT * DM * 2;
constexpr size_t WS_MKB = WS_AMEM + (size_t)MMEM * DM * 2;
constexpr size_t WS_MVB = WS_MKB + (size_t)DEPTH * MMEM * 512 * 2;
constexpr size_t WS_CAK = WS_MVB + (size_t)DEPTH * MMEM * 512 * 2;
constexpr size_t N_CA = (size_t)DEPTH * SBATCH * 128 * 2 * HD, N_CB = (size_t)DEPTH * SBATCH * 512 * 4 * HD, N_CM = (size_t)DEPTH * SBATCH * NMEM * 4 * HD;
constexpr size_t WS_CAV = WS_CAK + N_CA * 2, WS_CBK = WS_CAV + N_CA * 2, WS_CBV = WS_CBK + N_CB * 2, WS_CMK = WS_CBV + N_CB * 2, WS_CMV = WS_CMK + N_CM * 2;
constexpr size_t WS_HID = WS_CMV + N_CM * 2;
constexpr size_t WS_PROJ = WS_HID, WS_OB = WS_PROJ + (size_t)MT * INC * 2;
constexpr size_t SZ_HID = (size_t)MT * DFF * 2, SZ_PO = (size_t)MT * INC * 2 + (size_t)MT * DM * 2;
constexpr size_t WS_END = WS_HID + (SZ_HID > SZ_PO ? SZ_HID : SZ_PO);
static_assert(WS_END < (size_t)1400 * MiB, "workspace budget");
static_assert(WS_W % 256 == 0 && LW_END % 256 == 0 && WS_H % 256 == 0 && WS_HID % 256 == 0 && WS_OB % 256 == 0, "alignment");

constexpr int CW_BAR = 4096;
constexpr int RING_BYTES = 131072, LDSCTL_OFF = RING_BYTES, MISC_OFF = LDSCTL_OFF + 320, LDS_BYTES = 147456;
constexpr int NWAVES = 8;

#define GAS __attribute__((address_space(1)))
#define LAS __attribute__((address_space(3)))
typedef unsigned short bf16;
typedef unsigned v4u __attribute__((ext_vector_type(4)));
typedef float f32x4 __attribute__((ext_vector_type(4)));
typedef short bf16x8 __attribute__((ext_vector_type(8)));
#define LDS_WAIT() asm volatile("s_waitcnt lgkmcnt(0)" ::: "memory")
#define VM_WAIT() asm volatile("s_waitcnt vmcnt(0)" ::: "memory")
__device__ __forceinline__ unsigned pk2(float lo, float hi) { return pg8::cvt_pk_bf16(lo, hi); }
__device__ __forceinline__ float bf_lo(unsigned w) { return __uint_as_float(w << 16); }
__device__ __forceinline__ float bf_hi(unsigned w) { return __uint_as_float(w & 0xffff0000u); }

#define XB_TMO      128
#define XB_XCNT(j)  (256  + 64 * (j))
#define XB_XSUB(j)  (1280 + 64 * (j))
#define XB_XGEN(j)  (2304 + 64 * (j))
#define XB_TOP      3328
#define XB_TOPGEN   3392
#define XCD_BAR_WORDS 3456
#define XB_SPIN_CAP (1u << 18)
__device__ __forceinline__ unsigned xb_ld(unsigned* p)              { return __hip_atomic_load(p, __ATOMIC_RELAXED, __HIP_MEMORY_SCOPE_AGENT); }
__device__ __forceinline__ unsigned xb_add(unsigned* p, unsigned v) { return __hip_atomic_fetch_add(p, v, __ATOMIC_RELAXED, __HIP_MEMORY_SCOPE_AGENT); }
__device__ __forceinline__ unsigned xb_xcc_id() { return (unsigned)__builtin_amdgcn_s_getreg((3 << 11) | 20) & 0xFu; }
#define XB_SPIN(cond, bar) do { unsigned _sp = 0; while (cond) { __builtin_amdgcn_s_sleep(1); \
    if ((++_sp & 255u) == 0u) { if (xb_ld(&(bar)[XB_TMO])) break; if (_sp > XB_SPIN_CAP) { atomicAdd(&(bar)[XB_TMO], 1u); break; } } } } while (0)
struct XcdBarrier { unsigned* bar; unsigned x; volatile LAS unsigned* st; };
__device__ __forceinline__ XcdBarrier xcd_barrier_post(unsigned* bar, volatile LAS unsigned* st) {
    XcdBarrier b; b.bar = bar; b.x = xb_xcc_id(); b.st = st;
    if (threadIdx.x == 0) (void)xb_add(&bar[XB_XCNT(b.x)], 1u);
    return b;
}
__device__ __forceinline__ void xcd_barrier_complete(unsigned* bar, unsigned x, unsigned& nloc, unsigned& nx) {
    const unsigned G = gridDim.x * gridDim.y * gridDim.z;
    unsigned sum, cnt, mine, sp = 0u;
    for (;;) {
        sum = 0u; cnt = 0u; mine = 0u;
#pragma unroll
        for (unsigned j = 0; j < 16; ++j) { const unsigned c = xb_ld(&bar[XB_XCNT(j)]); sum += c; cnt += (c > 0u) ? 1u : 0u; mine = (j == x) ? c : mine; }
        if (sum == G) break;
        __builtin_amdgcn_s_sleep(1);
        if ((++sp & 255u) == 0u) { if (xb_ld(&bar[XB_TMO])) break; if (sp > XB_SPIN_CAP) { atomicAdd(&bar[XB_TMO], 1u); break; } }
    }
    nloc = mine > 0u ? mine : 1u; nx = cnt > 0u ? cnt : 1u;
}
__device__ __forceinline__ void xcd_barrier(const XcdBarrier& b) {
    asm volatile("s_waitcnt vmcnt(0)" ::: "memory");
    __syncthreads();
    if (threadIdx.x == 0) {
        unsigned* bar = b.bar;
        __builtin_amdgcn_s_waitcnt(0);
        unsigned nloc = b.st[0], nx = b.st[1];
        if (nloc == 0u) { xcd_barrier_complete(bar, b.x, nloc, nx); b.st[0] = nloc; b.st[1] = nx; }
        const unsigned old = xb_add(&bar[XB_XSUB(b.x)], 1u);
        const unsigned gen = old / nloc;
        if (old + 1u == (gen + 1u) * nloc) {
            __builtin_amdgcn_fence(__ATOMIC_RELEASE, "agent");
            asm volatile("s_waitcnt vmcnt(0)" ::: "memory");
            const unsigned og = xb_add(&bar[XB_TOP], 1u);
            const unsigned tg = og / nx;
            if (og + 1u == (tg + 1u) * nx) xb_add(&bar[XB_TOPGEN], 1u);
            else XB_SPIN(xb_ld(&bar[XB_TOPGEN]) == tg, bar);
            __builtin_amdgcn_fence(__ATOMIC_ACQUIRE, "agent");
            xb_add(&bar[XB_XGEN(b.x)], 1u);
            asm volatile("s_waitcnt vmcnt(0)" ::: "memory");
        } else {
            XB_SPIN(xb_ld(&bar[XB_XGEN(b.x)]) == gen, bar);
            __builtin_amdgcn_fence(__ATOMIC_ACQUIRE, "agent");
            asm volatile("s_waitcnt vmcnt(0)" ::: "memory");
        }
    }
    __syncthreads();
}

struct EpiSwiGLU {
    static constexpr bool PERM = true, AFTER_DRAIN = false;
    bf16* O;
    __device__ __forceinline__ void operator()(const pg8::f32x4 (&acc)[2][2][4][2], const pg8::Unit& u, int wr, int wc, int fr, int fq) const {
        const int row0 = u.pm * 256 + wr * 64 + fr, col0 = u.pn * 128 + wc * 32 + 8 * fq;
#pragma unroll
        for (int ai = 0; ai < 2; ++ai)
#pragma unroll
            for (int m = 0; m < 4; ++m) {
                bf16* rowp = O + (size_t)(row0 + ai * 128 + m * 16) * DFF + col0;
                float h[8];
#pragma unroll
                for (int n = 0; n < 2; ++n)
#pragma unroll
                    for (int j = 0; j < 4; ++j) { const float g = acc[ai][0][m][n][j], up = acc[ai][1][m][n][j];
                        const float e = __builtin_amdgcn_exp2f(-g * LOG2E); h[n * 4 + j] = g * __builtin_amdgcn_rcpf(1.0f + e) * up; }
                v4u w; w.x = pk2(h[0], h[1]); w.y = pk2(h[2], h[3]); w.z = pk2(h[4], h[5]); w.w = pk2(h[6], h[7]);
                *(v4u*)rowp = w; }
    }
};
struct EpiResid {
    static constexpr bool PERM = false, AFTER_DRAIN = false;
    const float* resP; const float* resS; float* dst; float scale;
    __device__ __forceinline__ void operator()(const pg8::f32x4 (&acc)[2][2][4][2], const pg8::Unit& u, int wr, int wc, int fr, int fq) const {
        const int rloc = wr * 64 + fr, col0 = u.pn * 256 + wc * 32 + 4 * fq;
        const float* rb = (u.pm < MP / 256) ? resP + (size_t)u.pm * 256 * DM : resS;
        float* db = dst + (size_t)u.pm * 256 * DM;
#pragma unroll
        for (int ai = 0; ai < 2; ++ai)
#pragma unroll
            for (int m = 0; m < 4; ++m) { const size_t off = (size_t)(rloc + ai * 128 + m * 16) * DM + col0;
#pragma unroll
                for (int bj = 0; bj < 2; ++bj)
#pragma unroll
                    for (int n = 0; n < 2; ++n) { const f32x4 r = *(const f32x4*)(rb + off + bj * 128 + n * 16); *(f32x4*)(db + off + bj * 128 + n * 16) = r + acc[ai][bj][m][n] * scale; }
                asm volatile("" ::: "memory"); }
    }
};
struct EpiProj {
    static constexpr bool PERM = true, AFTER_DRAIN = false;
    bf16* O;
    __device__ __forceinline__ void operator()(const pg8::f32x4 (&acc)[2][2][4][2], const pg8::Unit& u, int wr, int wc, int fr, int fq) const {
        const int row0 = u.pm * 256 + wr * 64 + fr, col0 = u.pn * 256 + wc * 32 + 8 * fq;
#pragma unroll
        for (int ai = 0; ai < 2; ++ai)
#pragma unroll
            for (int m = 0; m < 4; ++m) { bf16* rowp = O + (size_t)(row0 + ai * 128 + m * 16) * INC + col0;
#pragma unroll
                for (int bj = 0; bj < 2; ++bj) { const f32x4 v0 = acc[ai][bj][m][0], v1 = acc[ai][bj][m][1];
                    v4u w; w.x = pk2(v0[0], v0[1]); w.y = pk2(v0[2], v0[3]); w.z = pk2(v1[0], v1[1]); w.w = pk2(v1[2], v1[3]);
                    *(v4u*)(rowp + bj * 128) = w; } }
    }
};
struct EpiMem {
    static constexpr bool PERM = false, AFTER_DRAIN = false;
    float* outK;
    __device__ __forceinline__ void operator()(const pg8::f32x4 (&acc)[2][2][4][2], const pg8::Unit& u, int wr, int wc, int fr, int fq) const {
        const int l = u.pn >> 2, part = (u.pn >> 1) & 1, half = u.pn & 1;
        float* base = outK + (size_t)part * (O_MVP - O_MKP) + (size_t)l * MMEM * 512 + (size_t)u.pm * 256 * 512;
        const int rloc = wr * 64 + fr, col0 = half * 256 + wc * 32 + 4 * fq;
#pragma unroll
        for (int ai = 0; ai < 2; ++ai)
#pragma unroll
            for (int m = 0; m < 4; ++m) { float* rowp = base + (size_t)(rloc + ai * 128 + m * 16) * 512 + col0;
#pragma unroll
                for (int bj = 0; bj < 2; ++bj)
#pragma unroll
                    for (int n = 0; n < 2; ++n) *(f32x4*)(rowp + bj * 128 + n * 16) = acc[ai][bj][m][n]; }
    }
};

__device__ __forceinline__ float wave_sum(float v) {
    v += swz_xor<1>(v); v += swz_xor<2>(v); v += swz_xor<4>(v); v += swz_xor<8>(v); v += swz_xor<16>(v);
    auto rr = __builtin_amdgcn_permlane32_swap(__float_as_uint(v), __float_as_uint(v), false, false);
    return __uint_as_float(rr[0]) + __uint_as_float(rr[1]);
}
__device__ __forceinline__ float sum16(float v) {
    v += swz_xor<1>(v); v += swz_xor<2>(v); v += swz_xor<4>(v); v += swz_xor<8>(v); return v;
}
__device__ __forceinline__ void tr_item(const float* W, int N, int K, bf16* WT, int k0, int nsrc0, int ndst0, const float* gs, LAS float* scr, int lane) {
#pragma unroll 8
    for (int i = 0; i < 32; ++i) { const int kk = 2 * i + (lane >> 5); float v = W[(size_t)(k0 + kk) * N + nsrc0 + (lane & 31)]; if (gs) v *= gs[k0 + kk]; scr[kk * 33 + (lane & 31)] = v; }
    LDS_WAIT(); asm volatile("" ::: "memory");
    const int c = lane & 7;
#pragma unroll
    for (int j = 0; j < 4; ++j) { const int n = (lane >> 3) + 8 * j; const LAS float* s = scr + (8 * c) * 33 + n;
        v4u o; o.x = pk2(s[0 * 33], s[1 * 33]); o.y = pk2(s[2 * 33], s[3 * 33]); o.z = pk2(s[4 * 33], s[5 * 33]); o.w = pk2(s[6 * 33], s[7 * 33]);
        *(GAS v4u*)(WT + (size_t)(ndst0 + n) * K + k0 + 8 * c) = o; }
    LDS_WAIT(); asm volatile("" ::: "memory");
}
__device__ __forceinline__ void rms_row_to_bf16(const float* xrow, const float* g, bf16* orow, int lane) {
    const GAS f32x4* xr = (const GAS f32x4*)xrow + lane;
    f32x4 v[8]; float s = 0.f;
#pragma unroll
    for (int j = 0; j < 8; ++j) { v[j] = xr[64 * j]; s += (v[j].x * v[j].x + v[j].y * v[j].y) + (v[j].z * v[j].z + v[j].w * v[j].w); }
    const float rstd = 1.0f / sqrtf(wave_sum(s) * (1.f / DM) + EPS);
    GAS unsigned long long* o8 = (GAS unsigned long long*)orow + lane;
#pragma unroll
    for (int j = 0; j < 8; ++j) { f32x4 gg = (f32x4){1.f, 1.f, 1.f, 1.f}; if (g) gg = ((const GAS f32x4*)g)[lane + 64 * j];
        o8[64 * j] = (unsigned long long)pk2(v[j].x * rstd * gg.x, v[j].y * rstd * gg.y) | ((unsigned long long)pk2(v[j].z * rstd * gg.z, v[j].w * rstd * gg.w) << 32); }
}

__constant__ double ROPE_REV[16] = {0.15915494309189535, 0.0700865215877985, 0.03086376340470123, 0.013591370636193905, 0.005985185712713705, 0.002635675898667414,
    0.001160663641240061, 0.0005111175045375439, 0.00022507907903927653, 9.911730936901935e-05, 4.364795279280289e-05, 1.9221100684944863e-05,
    8.464330808241401e-06, 3.727408601915352e-06, 1.6414262627950345e-06, 7.228293068832865e-07};

namespace att {
typedef short s16x4 __attribute__((ext_vector_type(4)));
typedef float f32x16 __attribute__((ext_vector_type(16)));
typedef unsigned u32x4 __attribute__((ext_vector_type(4)));
#define KSWZ(row, colB) ((row) * 256 + ((colB) ^ (((row) & 7) << 4)))
__device__ __forceinline__ int crow(int r, int hi) { return (r & 3) + 8 * (r >> 2) + 4 * hi; }
__device__ __forceinline__ int v_st(int k, int c) { const int kk = (k & ~0xC) | ((k & 4) << 1) | ((k & 8) >> 1); return ((kk >> 3) * 4 + (c >> 5)) * 512 + ((kk & 7) * 32 + (c & 31)) * 2; }
__device__ __forceinline__ int v_rd_base(int lane) { return ((lane & 3) << 3) | (((lane >> 2) & 3) << 6) | (((lane >> 4) & 1) << 5) | (((lane >> 5) & 1) << 8); }
constexpr int v_rd_off(int d0, int ks, int half) { return d0 * 512 + ks * 4096 + half * 2048; }
template <int OFF> __device__ __forceinline__ s16x4 tr_read(int vb) {
    s16x4 r; asm volatile("ds_read_b64_tr_b16 %0, %1 offset:%2" : "=&v"(r) : "v"(vb), "i"(OFF) : "memory"); return r;
}
template <int D0> __device__ __forceinline__ void pv_one(f32x16& od, int vb, bf16x8 pa0, bf16x8 pa1, bf16x8 pa2, bf16x8 pa3) {
    const s16x4 l0 = tr_read<v_rd_off(D0, 0, 0)>(vb), h0 = tr_read<v_rd_off(D0, 0, 1)>(vb), l1 = tr_read<v_rd_off(D0, 1, 0)>(vb), h1 = tr_read<v_rd_off(D0, 1, 1)>(vb);
    const s16x4 l2 = tr_read<v_rd_off(D0, 2, 0)>(vb), h2 = tr_read<v_rd_off(D0, 2, 1)>(vb), l3 = tr_read<v_rd_off(D0, 3, 0)>(vb), h3 = tr_read<v_rd_off(D0, 3, 1)>(vb);
    asm volatile("s_waitcnt lgkmcnt(0)" ::: "memory"); __builtin_amdgcn_sched_barrier(0);
#define PKV(L, H) (bf16x8){L[0], L[1], L[2], L[3], H[0], H[1], H[2], H[3]}
    od = __builtin_amdgcn_mfma_f32_32x32x16_bf16(pa0, PKV(l0, h0), od, 0, 0, 0);
    od = __builtin_amdgcn_mfma_f32_32x32x16_bf16(pa1, PKV(l1, h1), od, 0, 0, 0);
    od = __builtin_amdgcn_mfma_f32_32x32x16_bf16(pa2, PKV(l2, h2), od, 0, 0, 0);
    od = __builtin_amdgcn_mfma_f32_32x32x16_bf16(pa3, PKV(l3, h3), od, 0, 0, 0);
#undef PKV
}
struct Params {
    const bf16* q; bf16* o; int ldq; int active;
    const bf16 *k0, *v0; int ld0, n0;
    const bf16 *k1, *v1; int ld1, nv1;
    int ntile, tlo, thi;
    float m0, l0;
    int bias, tboff, i0;
};
__device__ __forceinline__ void unit(LAS unsigned char* lds, const Params& P, LAS float* tab, const float* tabsrc, const int wid) {
    const int lane = lane_id_opaque();
    const int tid = wid * 64 + lane, r32 = lane & 31, hi = lane >> 5;
    if (tabsrc != nullptr && tid < 257) tab[tid] = tabsrc[tid] * LOG2E;
    LAS float* wsf = (LAS float*)(lds + 65536 + wid * 256); LAS float* li_l = wsf; LAS float* al_l = wsf + 32;
    const int ldsbase = (int)(unsigned)(uintptr_t)lds;
    bf16x8 qr[8];
    if (P.active) {
        const bf16* Qw = P.q + (size_t)r32 * P.ldq + hi * 8;
#pragma unroll
        for (int d0 = 0; d0 < 8; ++d0) qr[d0] = *(const bf16x8*)(Qw + d0 * 16);
    } else {
#pragma unroll
        for (int d0 = 0; d0 < 8; ++d0) qr[d0] = (bf16x8){0, 0, 0, 0, 0, 0, 0, 0};
    }
    float m_reg = P.m0, l_reg = P.l0;
    f32x16 o[4];
#pragma unroll
    for (int d = 0; d < 4; ++d)
#pragma unroll
        for (int r = 0; r < 16; ++r) o[d][r] = 0.f;
    const int sr = tid >> 4, sc = (tid & 15) * 8;
    const int vst0 = v_st(sr, sc), vst1 = v_st(32 + sr, sc), kst0 = KSWZ(sr, sc * 2), kst1 = KSWZ(32 + sr, sc * 2);
    bf16x8 ks0, ks1, vs0, vs1;
    const bf16x8 zero8 = (bf16x8){0, 0, 0, 0, 0, 0, 0, 0};
#define ATT_LOAD(t) do { const bool s0 = (t) < P.n0; const bf16* kp = s0 ? P.k0 + (size_t)(t) * 64 * P.ld0 : P.k1; const bf16* vp = s0 ? P.v0 + (size_t)(t) * 64 * P.ld0 : P.v1; \
        const int ld = s0 ? P.ld0 : P.ld1, nv = s0 ? 64 : P.nv1; \
        ks0 = zero8; ks1 = zero8; vs0 = zero8; vs1 = zero8; \
        if (sr < nv) { ks0 = *(const bf16x8*)(kp + (size_t)sr * ld + sc); vs0 = *(const bf16x8*)(vp + (size_t)sr * ld + sc); } \
        if (32 + sr < nv) { ks1 = *(const bf16x8*)(kp + (size_t)(32 + sr) * ld + sc); vs1 = *(const bf16x8*)(vp + (size_t)(32 + sr) * ld + sc); } } while (0)
    const int NT = P.ntile;
    ATT_LOAD(0);
    for (int t = 0; t < NT; ++t) {
        const int buf = t & 1;
        asm volatile("s_waitcnt vmcnt(0)" ::: "memory");
        LAS unsigned char* Kb = lds + buf * 16384; LAS unsigned char* Vb = lds + 32768 + buf * 16384;
        *(LAS bf16x8*)(Kb + kst0) = ks0; *(LAS bf16x8*)(Kb + kst1) = ks1; *(LAS bf16x8*)(Vb + vst0) = vs0; *(LAS bf16x8*)(Vb + vst1) = vs1;
        if (t + 1 < NT) ATT_LOAD(t + 1);
        __syncthreads();
        if (P.active && t >= P.tlo && t <= P.thi) {
            f32x16 p0, p1;
#pragma unroll
            for (int r = 0; r < 16; ++r) { p0[r] = 0.f; p1[r] = 0.f; }
#pragma unroll
            for (int d0 = 0; d0 < 8; ++d0) { const int cb = (d0 * 16 + hi * 8) * 2;
                const bf16x8 b0 = *(const LAS bf16x8*)(Kb + KSWZ(r32, cb)); const bf16x8 b1 = *(const LAS bf16x8*)(Kb + KSWZ(32 + r32, cb));
                p0 = __builtin_amdgcn_mfma_f32_32x32x16_bf16(b0, qr[d0], p0, 0, 0, 0);
                p1 = __builtin_amdgcn_mfma_f32_32x32x16_bf16(b1, qr[d0], p1, 0, 0, 0); }
            constexpr float C = 0.088388347648318440f * LOG2E;
            if (P.bias) {
                const int tb = t - P.tboff;
                if (tb <= 5) { const float bc = tab[256];
#pragma unroll
                    for (int r = 0; r < 16; ++r) { p0[r] = fmaf(p0[r], C, bc); p1[r] = fmaf(p1[r], C, bc); } }
                else { const int base = 512 - 64 * tb + P.i0 + r32 + 128;
#pragma unroll
                    for (int r = 0; r < 16; ++r) { const int kk = crow(r, hi); int i0x = base - kk, i1x = base - kk - 32; i0x = i0x > 256 ? 256 : i0x; i1x = i1x > 256 ? 256 : i1x;
                        p0[r] = fmaf(p0[r], C, tab[i0x]); p1[r] = fmaf(p1[r], C, tab[i1x]); } }
            } else {
#pragma unroll
                for (int r = 0; r < 16; ++r) { p0[r] *= C; p1[r] *= C; }
            }
            const int nv = (t < P.n0) ? 64 : P.nv1;
            if (nv < 64) {
#pragma unroll
                for (int r = 0; r < 16; ++r) { const int kk = crow(r, hi); if (kk >= nv) p0[r] = -1e30f; if (kk + 32 >= nv) p1[r] = -1e30f; }
            }
            float pmax = p0[0];
#pragma unroll
            for (int r = 1; r < 16; ++r) pmax = fmaxf(pmax, p0[r]);
#pragma unroll
            for (int r = 0; r < 16; ++r) pmax = fmaxf(pmax, p1[r]);
            { auto rr = __builtin_amdgcn_permlane32_swap(__float_as_uint(pmax), __float_as_uint(pmax), false, false);
              pmax = fmaxf(__uint_as_float(rr[0]), __uint_as_float(rr[1])); }
            const float mn = fmaxf(m_reg, pmax); const float alpha = __builtin_amdgcn_exp2f(m_reg - mn); m_reg = mn;
            float ps = 0.f;
#pragma unroll
            for (int r = 0; r < 16; ++r) { p0[r] = __builtin_amdgcn_exp2f(p0[r] - mn); p1[r] = __builtin_amdgcn_exp2f(p1[r] - mn); ps += p0[r] + p1[r]; }
            { auto rr = __builtin_amdgcn_permlane32_swap(__float_as_uint(ps), __float_as_uint(ps), false, false);
              ps = __uint_as_float(rr[0]) + __uint_as_float(rr[1]); }
            l_reg = l_reg * alpha + ps;
            if (__any(alpha < 1.f)) { if (hi == 0) al_l[r32] = alpha; asm volatile("s_waitcnt lgkmcnt(0)" ::: "memory");
#pragma unroll
                for (int r = 0; r < 16; ++r) { const float a = al_l[crow(r, hi)];
#pragma unroll
                    for (int d = 0; d < 4; ++d) o[d][r] *= a; } }
            bf16x8 pa0, pa1, pa2, pa3;
#define PK4(P_, BASE, OUT) do { unsigned a0 = pk2(P_[BASE + 0], P_[BASE + 1]), a1 = pk2(P_[BASE + 2], P_[BASE + 3]);   \
    unsigned b0 = pk2(P_[BASE + 4], P_[BASE + 5]), b1 = pk2(P_[BASE + 6], P_[BASE + 7]);                              \
    auto r0 = __builtin_amdgcn_permlane32_swap(a0, b0, false, false); auto r1 = __builtin_amdgcn_permlane32_swap(a1, b1, false, false); \
    u32x4 w = {r0[0], r1[0], r0[1], r1[1]}; OUT = __builtin_bit_cast(bf16x8, w); } while (0)
            PK4(p0, 0, pa0); PK4(p0, 8, pa1); PK4(p1, 0, pa2); PK4(p1, 8, pa3);
#undef PK4
            const int vb = ldsbase + 32768 + buf * 16384 + v_rd_base(lane);
            pv_one<0>(o[0], vb, pa0, pa1, pa2, pa3); pv_one<1>(o[1], vb, pa0, pa1, pa2, pa3); pv_one<2>(o[2], vb, pa0, pa1, pa2, pa3); pv_one<3>(o[3], vb, pa0, pa1, pa2, pa3);
        }
    }
#undef ATT_LOAD
    if (P.active) {
        if (hi == 0) li_l[r32] = l_reg; asm volatile("s_waitcnt lgkmcnt(0)" ::: "memory");
#pragma unroll
        for (int r = 0; r < 16; ++r) { const int orow = crow(r, hi); const float rl = __builtin_amdgcn_rcpf(li_l[orow]);
            bf16* op = P.o + (size_t)orow * MIXW + r32;
#pragma unroll
            for (int d0 = 0; d0 < 4; ++d0) op[d0 * 32] = (bf16)(pk2(o[d0][r] * rl, 0.f) & 0xffffu); }
    }
    __syncthreads();
}
}

struct Args { const float* in[23]; float* out; unsigned char* ws; };
enum { I_XP = 0, I_XS, I_CAK, I_CAV, I_CBK, I_CBV, I_CMK, I_CMV, I_MEM, I_NFF1, I_WFF1I, I_WFF1O, I_NMIX, I_WIN, I_QKG, I_SINK, I_REL, I_NMEM, I_WMEM, I_WOUT, I_NFF2, I_WFF2I, I_WFF2O };

#define CAS __attribute__((address_space(4)))
__global__ void __launch_bounds__(NWAVES * 64, 2) enc_fwd(Args args) {
    extern __shared__ __attribute__((aligned(16))) unsigned char lds_raw[];
    LAS unsigned char* lds = (LAS unsigned char*)lds_raw;
    volatile LAS unsigned* MISC = (volatile LAS unsigned*)(lds + MISC_OFF);
    const int G0 = gridDim.x, bx0 = blockIdx.x, wave0 = __builtin_amdgcn_readfirstlane((int)threadIdx.x >> 6);
    unsigned char* const ws0 = args.ws; float* const out0 = args.out;
    const float* const CAS* const ain0 = (const float* const CAS*)__builtin_amdgcn_kernarg_segment_ptr();
#define PHASE_IDS() \
    const int lane = lane_id_opaque(); \
    int G = G0, bx = bx0, wave = wave0; unsigned long long ws_i = (unsigned long long)ws0, out_i = (unsigned long long)out0; const float* const CAS* ain = ain0; \
    asm volatile("" : "+s"(G), "+s"(bx), "+s"(wave), "+s"(ws_i), "+s"(out_i), "+s"(ain)); \
    unsigned char* const ws = (unsigned char*)(GAS unsigned char*)ws_i; float* const out = (float*)(GAS float*)out_i;     \
    const int tid = wave * 64 + lane, vcu = (G % 8 == 0) ? (bx % 8) * (G / 8) + bx / 8 : bx, NGW = G * NWAVES, gw = vcu * NWAVES + wave; \
    (void)tid; (void)gw; (void)NGW; (void)out; (void)ain; (void)ws
#define WSP(off) ((bf16*)(ws + (off)))
#define AIN(i) ((const float*)(const GAS float*)ain[i])
    for (int u = threadIdx.x; u < (LDS_BYTES - LDSCTL_OFF) / 4; u += NWAVES * 64) ((LAS unsigned*)(lds + LDSCTL_OFF))[u] = 0u;
    __syncthreads();
    XcdBarrier bar = xcd_barrier_post((unsigned*)(ws0 + WS_CTL) + CW_BAR, MISC + 8);
#define GRID_BAR() xcd_barrier(bar)

    {
        PHASE_IDS();
        LAS float* scr = (LAS float*)(lds + wave * 16384);
        constexpr int IT_A = (DM / 64) * (2 * DFF / 32), IT_B = (DFF / 64) * (DM / 32), IT_IN = (DM / 64) * (INC / 32), IT_OUT = (MIXW / 64) * (DM / 32), IT_MEM = (DM / 64) * (1024 / 32);
        constexpr int IT_L = 2 * IT_A + 2 * IT_B + IT_IN + IT_OUT + IT_MEM;
        for (int it = gw; it < DEPTH * IT_L; it += NGW) {
            const int l = it / IT_L; int r = it % IT_L;
            unsigned char* lw = ws + WS_W + (size_t)l * LW_END;
            if (r < 2 * IT_A) {
                const int f = r / IT_A; r -= f * IT_A;
                const float* W = (f ? AIN(I_WFF2I) : AIN(I_WFF1I)) + (size_t)l * DM * 2 * DFF; bf16* WT = (bf16*)(lw + (f ? LW_W2A : LW_W1A));
                const int nblk = 2 * DFF / 32, kb = r / nblk, nb = r % nblk, nd = nb * 32;
                const int ns = ((nd & 255) >> 7) * DFF + (nd >> 8) * 128 + (nd & 127);
                tr_item(W, 2 * DFF, DM, WT, kb * 64, ns, nd, nullptr, scr, lane); continue; }
            r -= 2 * IT_A;
            if (r < 2 * IT_B) {
                const int f = r / IT_B; r -= f * IT_B;
                const float* W = (f ? AIN(I_WFF2O) : AIN(I_WFF1O)) + (size_t)l * DFF * DM; bf16* WT = (bf16*)(lw + (f ? LW_W2B : LW_W1B));
                const int nblk = DM / 32, kb = r / nblk, nb = r % nblk;
                tr_item(W, DM, DFF, WT, kb * 64, nb * 32, nb * 32, nullptr, scr, lane); continue; }
            r -= 2 * IT_B;
            if (r < IT_IN) { const float* W = AIN(I_WIN) + (size_t)l * DM * INC; bf16* WT = (bf16*)(lw + LW_WIN);
                const int nblk = INC / 32, kb = r / nblk, nb = r % nblk;
                tr_item(W, INC, DM, WT, kb * 64, nb * 32, nb * 32, nullptr, scr, lane); continue; }
            r -= IT_IN;
            if (r < IT_OUT) { const float* W = AIN(I_WOUT) + (size_t)l * MIXW * DM; bf16* WT = (bf16*)(lw + LW_WOUT);
                const int nblk = DM / 32, kb = r / nblk, nb = r % nblk;
                tr_item(W, DM, MIXW, WT, kb * 64, nb * 32, nb * 32, nullptr, scr, lane); continue; }
            r -= IT_OUT;
            { const float* W = AIN(I_WMEM) + (size_t)l * DM * 1024; bf16* WT = WSP(WS_WMEM) + (size_t)l * 1024 * DM;
                const int nblk = 1024 / 32, kb = r / nblk, nb = r % nblk;
                tr_item(W, 1024, DM, WT, kb * 64, nb * 32, nb * 32, AIN(I_NMEM) + (size_t)l * DM, scr, lane); }
        }
        {
            const size_t gt = (size_t)gw * 64 + lane, GT = (size_t)NGW * 64;
#define CVT_CACHE(IDX, NEL, OFF) do { const float* src = AIN(IDX); bf16* dst = WSP(OFF); \
                for (size_t i = gt; i < (NEL) / 8; i += GT) { const f32x4 a = *(const GAS f32x4*)(src + i * 8), b = *(const GAS f32x4*)(src + i * 8 + 4); \
                    v4u w; w.x = pk2(a.x, a.y); w.y = pk2(a.z, a.w); w.z = pk2(b.x, b.y); w.w = pk2(b.z, b.w); *(GAS v4u*)(dst + i * 8) = w; } } while (0)
            CVT_CACHE(I_CAK, N_CA, WS_CAK); CVT_CACHE(I_CAV, N_CA, WS_CAV); CVT_CACHE(I_CBK, N_CB, WS_CBK); CVT_CACHE(I_CBV, N_CB, WS_CBV); CVT_CACHE(I_CMK, N_CM, WS_CMK); CVT_CACHE(I_CMV, N_CM, WS_CMV);
#undef CVT_CACHE
        }
        for (int m = gw; m < MMEM; m += NGW) rms_row_to_bf16(AIN(I_MEM) + (size_t)m * DM, nullptr, WSP(WS_AMEM) + (size_t)m * DM, lane);
        for (int m = gw; m < MT; m += NGW) { const float* xr = (m < MP) ? AIN(I_XP) + (size_t)m * DM : AIN(I_XS) + (size_t)(m - MP) * DM;
            rms_row_to_bf16(xr, AIN(I_NFF1), WSP(WS_H) + (size_t)m * DM, lane); }
    }
    GRID_BAR();
    {
        PHASE_IDS();
        pg8::Gemm g{WSP(WS_AMEM), WSP(WS_WMEM), MMEM, DEPTH * 1024, DM}; pg8::StaticOrder S; S.init(MMEM, DEPTH * 1024, G, bx);
        EpiMem E{out + O_MKP};
        pg8::gemm_phase<EpiMem, pg8::StaticOrder, true, true>(lds, g, S, E, wave);
    }
    GRID_BAR();
    { PHASE_IDS();
    for (int it = gw; it < DEPTH * MMEM; it += NGW) {
        const int l = it / MMEM; const size_t off = (size_t)it * 512 + lane * 8;
        const float* gk = AIN(I_QKG) + ((size_t)l * 6 + 5) * HD + (lane & 15) * 8;
        float* kp = out + O_MKP + off; const float* vp = out + O_MVP + off;
        f32x4 a = *(const GAS f32x4*)kp, b = *(const GAS f32x4*)(kp + 4);
        float ss = (a.x * a.x + a.y * a.y) + (a.z * a.z + a.w * a.w) + (b.x * b.x + b.y * b.y) + (b.z * b.z + b.w * b.w);
        const float rstd = 1.0f / sqrtf(sum16(ss) * (1.f / HD) + EPS);
        const f32x4 g0 = *(const GAS f32x4*)gk, g1 = *(const GAS f32x4*)(gk + 4);
        a = a * rstd * g0; b = b * rstd * g1;
        *(GAS f32x4*)kp = a; *(GAS f32x4*)(kp + 4) = b;
        v4u w; w.x = pk2(a.x, a.y); w.y = pk2(a.z, a.w); w.z = pk2(b.x, b.y); w.w = pk2(b.z, b.w); *(GAS v4u*)(WSP(WS_MKB) + off) = w;
        const f32x4 c = *(const GAS f32x4*)vp, d = *(const GAS f32x4*)(vp + 4);
        w.x = pk2(c.x, c.y); w.y = pk2(c.z, c.w); w.z = pk2(d.x, d.y); w.w = pk2(d.z, d.w); *(GAS v4u*)(WSP(WS_MVB) + off) = w;
    } }

    for (int l = 0; l < DEPTH; ++l) {
        {
            PHASE_IDS();
            pg8::Gemm g{WSP(WS_H), WSP(WS_W + (size_t)l * LW_END + LW_W1A), MT, 2 * DFF, DM}; pg8::StaticOrder S; S.init(MT, 2 * DFF, G, bx);
            EpiSwiGLU E{WSP(WS_HID)};
            pg8::gemm_phase<EpiSwiGLU, pg8::StaticOrder, true, true>(lds, g, S, E, wave);
        }
        GRID_BAR();
        {
            PHASE_IDS();
            pg8::Gemm g{WSP(WS_HID), WSP(WS_W + (size_t)l * LW_END + LW_W1B), MT, DM, DFF}; pg8::StaticOrder S; S.init(MT, DM, G, bx);
            EpiResid E{l == 0 ? AIN(I_XP) : out + O_YP, l == 0 ? AIN(I_XS) : out + O_YS, out, 0.5f};
            pg8::gemm_phase<EpiResid, pg8::StaticOrder, true, true>(lds, g, S, E, wave);
        }
        GRID_BAR();
        { PHASE_IDS(); for (int m = gw; m < MT; m += NGW) rms_row_to_bf16(out + (size_t)m * DM, AIN(I_NMIX) + (size_t)l * DM, WSP(WS_H) + (size_t)m * DM, lane); }
        GRID_BAR();
        {
            PHASE_IDS();
            pg8::Gemm g{WSP(WS_H), WSP(WS_W + (size_t)l * LW_END + LW_WIN), MT, INC, DM}; pg8::StaticOrder S; S.init(MT, INC, G, bx);
            EpiProj E{WSP(WS_PROJ)};
            pg8::gemm_phase<EpiProj, pg8::StaticOrder, true, true>(lds, g, S, E, wave);
        }
        GRID_BAR();
        {
            PHASE_IDS();
            bf16* PROJ = WSP(WS_PROJ);
            const int li = lane & 15, grp = lane >> 4;
            const float* qkg = AIN(I_QKG) + (size_t)l * 6 * HD + li * 8;
            for (int row = gw; row < MT; row += NGW) {
                bf16* pr = PROJ + (size_t)row * INC;
                int b, t, pos; const bool isP = row < MP;
                if (isP) { b = row >> 12; t = row & 4095; pos = t; } else { const int s = row - MP; b = s >> 5; t = s & 31; pos = PAST + t; }
                float cs[8], sn[8];
#pragma unroll
                for (int j = 0; j < 8; ++j) { const double rev = (double)pos * ROPE_REV[8 * (li & 1) + j]; const float fr = (float)(rev - floor(rev));
                    cs[j] = __builtin_amdgcn_cosf(fr); sn[j] = __builtin_amdgcn_sinf(fr); }
#pragma unroll
                for (int s = 0; s < 7; ++s) {
                    const v4u raw = *(const GAS v4u*)(pr + s * 512 + lane * 8);
                    float x[8] = {bf_lo(raw.x), bf_hi(raw.x), bf_lo(raw.y), bf_hi(raw.y), bf_lo(raw.z), bf_hi(raw.z), bf_lo(raw.w), bf_hi(raw.w)};
                    const bool isv = (s == 5) || (s == 2 && grp >= 2);
                    const int gi = (s < 2) ? 0 : (s == 2) ? 1 : (s == 3) ? 2 : (s == 4) ? 3 : 4;
                    const bool rope = (s < 2) || (s == 2 && grp < 2);
                    if (s != 5) {
                        float ss = 0.f;
#pragma unroll
                        for (int j = 0; j < 8; ++j) ss += x[j] * x[j];
                        const float rstd = 1.0f / sqrtf(sum16(ss) * (1.f / HD) + EPS);
                        const f32x4 g0 = *(const GAS f32x4*)(qkg + gi * HD), g1 = *(const GAS f32x4*)(qkg + gi * HD + 4);
                        const float gg[8] = {g0.x, g0.y, g0.z, g0.w, g1.x, g1.y, g1.z, g1.w};
                        float y[8];
#pragma unroll
                        for (int j = 0; j < 8; ++j) y[j] = x[j] * rstd * gg[j];
                        if (s <= 2) {
#pragma unroll
                            for (int j = 0; j < 8; ++j) { const float oth = swz_xor<2>(y[j]);
                                const float rot = (li < 2) ? (y[j] * cs[j] - oth * sn[j]) : (y[j] * cs[j] + oth * sn[j]);
                                if (rope && li < 4) y[j] = rot; }
                        }
#pragma unroll
                        for (int j = 0; j < 8; ++j) x[j] = isv ? x[j] : y[j];
                        v4u w; w.x = pk2(x[0], x[1]); w.y = pk2(x[2], x[3]); w.z = pk2(x[4], x[5]); w.w = pk2(x[6], x[7]);
                        if (!isv) *(GAS v4u*)(pr + s * 512 + lane * 8) = w;
                    }
                    if (s == 2 || s == 4 || s == 5) {
                        float* dst = nullptr;
                        if (s == 2) { const int gh = grp & 1; const bool v = grp >= 2;
                            if (isP) { if (t >= SEQ - 128) dst = out + (v ? O_AVP : O_AKP) + ((((size_t)l * NBATCH + b) * 128 + (t - (SEQ - 128))) * 2 + gh) * HD; }
                            else dst = out + (v ? O_AVS : O_AKS) + ((((size_t)l * SBATCH + b) * SSEQ + t) * 2 + gh) * HD;
                        } else { const bool v = (s == 5);
                            if (isP) { if (t >= SEQ - 512) dst = out + (v ? O_BVP : O_BKP) + ((((size_t)l * NBATCH + b) * 512 + (t - (SEQ - 512))) * 4 + grp) * HD; }
                            else dst = out + (v ? O_BVS : O_BKS) + ((((size_t)l * SBATCH + b) * SSEQ + t) * 4 + grp) * HD;
                        }
                        if (dst) { dst += li * 8; *(GAS f32x4*)dst = (f32x4){x[0], x[1], x[2], x[3]}; *(GAS f32x4*)(dst + 4) = (f32x4){x[4], x[5], x[6], x[7]}; }
                    }
                }
            }
        }
        GRID_BAR();
        {
            PHASE_IDS();
            LAS float* tab = (LAS float*)(lds + 69632);
            bf16* PROJ = WSP(WS_PROJ); bf16* OB = WSP(WS_OB);
            constexpr int NUNITS = 512 + 512 + 1024 + 32 + 32 + 16;
            for (int u = bx; u < NUNITS; u += G) {
                att::Params P; P.ldq = INC; P.active = 1; P.k1 = nullptr; P.v1 = nullptr; P.ld1 = INC; P.nv1 = 64; P.m0 = -1e30f; P.l0 = 0.f; P.bias = 0; P.tboff = 0; P.i0 = 0;
                int bias_h = -1;
                if (u < 512) {
                    const int b = u >> 6, h = (u >> 4) & 3, c0 = (u & 15) * 4, cw = c0 + (wave >> 1), i0 = (wave & 1) * 32;
                    const size_t rowq = (size_t)b * SEQ + cw * 64 + i0;
                    P.q = PROJ + rowq * INC + C_QB + h * HD; P.o = OB + rowq * MIXW + (8 + h) * HD;
                    const int cfirst = c0 - 8 > 0 ? c0 - 8 : 0; P.ntile = c0 + 4 - cfirst; P.n0 = P.ntile;
                    P.k0 = PROJ + ((size_t)b * SEQ + cfirst * 64) * INC + C_KB + h * HD; P.v0 = PROJ + ((size_t)b * SEQ + cfirst * 64) * INC + C_VB + h * HD; P.ld0 = INC;
                    P.tboff = cw - 8 - cfirst; P.tlo = P.tboff > 0 ? P.tboff : 0; P.thi = cw - cfirst; P.bias = 1; P.i0 = i0; bias_h = h;
                } else if (u < 1024) {
                    const int v = u - 512, b = v >> 6, h = (v >> 4) & 3, qb = v & 15;
                    const size_t rowq = (size_t)b * SEQ + qb * 256 + wave * 32;
                    P.q = PROJ + rowq * INC + C_QM + h * HD; P.o = OB + rowq * MIXW + (12 + h) * HD;
                    P.ntile = 4; P.n0 = 4; P.k0 = WSP(WS_MKB) + ((size_t)l * MMEM + b * NMEM) * 512 + h * HD; P.v0 = WSP(WS_MVB) + ((size_t)l * MMEM + b * NMEM) * 512 + h * HD; P.ld0 = 512;
                    P.tlo = 0; P.thi = 3;
                } else if (u < 2048) {
                    const int v = u - 1024, b = v >> 7, c = (v >> 1) & 63, g = v & 1, hq = 4 * g + (wave >> 1), i0 = (wave & 1) * 32;
                    const size_t rowq = (size_t)b * SEQ + c * 64 + i0;
                    P.q = PROJ + rowq * INC + C_QA + hq * HD; P.o = OB + rowq * MIXW + hq * HD;
                    const int cfirst = c - 2 > 0 ? c - 2 : 0; P.ntile = c - cfirst + 1; P.n0 = P.ntile;
                    P.k0 = PROJ + ((size_t)b * SEQ + cfirst * 64) * INC + C_KA + g * HD; P.v0 = PROJ + ((size_t)b * SEQ + cfirst * 64) * INC + C_VA + g * HD; P.ld0 = INC;
                    P.tlo = 0; P.thi = P.ntile - 1; P.m0 = AIN(I_SINK)[l * 8 + hq] * LOG2E; P.l0 = 1.f;
                } else if (u < 2080) {
                    const int v = u - 2048, b = v >> 2, h = v & 3; const size_t rowq = (size_t)MP + b * SSEQ;
                    P.q = PROJ + rowq * INC + C_QB + h * HD; P.o = OB + rowq * MIXW + (8 + h) * HD; P.active = (wave == 0);
                    P.ntile = 9; P.n0 = 8; P.k0 = WSP(WS_CBK) + (((size_t)l * SBATCH + b) * 512) * 512 + h * HD; P.v0 = WSP(WS_CBV) + (((size_t)l * SBATCH + b) * 512) * 512 + h * HD; P.ld0 = 512;
                    P.k1 = PROJ + rowq * INC + C_KB + h * HD; P.v1 = PROJ + rowq * INC + C_VB + h * HD; P.nv1 = SSEQ;
                    P.tlo = 0; P.thi = 8; P.bias = 1; bias_h = h;
                } else if (u < 2112) {
                    const int v = u - 2080, b = v >> 2, h = v & 3; const size_t rowq = (size_t)MP + b * SSEQ;
                    P.q = PROJ + rowq * INC + C_QM + h * HD; P.o = OB + rowq * MIXW + (12 + h) * HD; P.active = (wave == 0);
                    P.ntile = 4; P.n0 = 4; P.k0 = WSP(WS_CMK) + (((size_t)l * SBATCH + b) * NMEM) * 512 + h * HD; P.v0 = WSP(WS_CMV) + (((size_t)l * SBATCH + b) * NMEM) * 512 + h * HD; P.ld0 = 512;
                    P.tlo = 0; P.thi = 3;
                } else {
                    const int v = u - 2112, b = v >> 1, g = v & 1, hq = 4 * g + (wave >> 1); const size_t rowq = (size_t)MP + b * SSEQ;
                    P.q = PROJ + rowq * INC + C_QA + hq * HD; P.o = OB + rowq * MIXW + hq * HD; P.active = ((wave & 1) == 0);
                    P.ntile = 3; P.n0 = 2; P.k0 = WSP(WS_CAK) + (((size_t)l * SBATCH + b) * 128) * 256 + g * HD; P.v0 = WSP(WS_CAV) + (((size_t)l * SBATCH + b) * 128) * 256 + g * HD; P.ld0 = 256;
                    P.k1 = PROJ + rowq * INC + C_KA + g * HD; P.v1 = PROJ + rowq * INC + C_VA + g * HD; P.nv1 = SSEQ;
                    P.tlo = 0; P.thi = 2; P.m0 = AIN(I_SINK)[l * 8 + hq] * LOG2E; P.l0 = 1.f;
                }
                att::unit(lds, P, tab, bias_h >= 0 ? AIN(I_REL) + ((size_t)l * 4 + bias_h) * 257 : nullptr, wave);
            }
        }
        GRID_BAR();
        {
            PHASE_IDS();
            pg8::Gemm g{WSP(WS_OB), WSP(WS_W + (size_t)l * LW_END + LW_WOUT), MT, DM, MIXW}; pg8::StaticOrder S; S.init(MT, DM, G, bx);
            EpiResid E{out + O_YP, out + O_YS, out, 1.0f};
            pg8::gemm_phase<EpiResid, pg8::StaticOrder, true, true>(lds, g, S, E, wave);
        }
        GRID_BAR();
        { PHASE_IDS(); for (int m = gw; m < MT; m += NGW) rms_row_to_bf16(out + (size_t)m * DM, AIN(I_NFF2) + (size_t)l * DM, WSP(WS_H) + (size_t)m * DM, lane); }
        GRID_BAR();
        {
            PHASE_IDS();
            pg8::Gemm g{WSP(WS_H), WSP(WS_W + (size_t)l * LW_END + LW_W2A), MT, 2 * DFF, DM}; pg8::StaticOrder S; S.init(MT, 2 * DFF, G, bx);
            EpiSwiGLU E{WSP(WS_HID)};
            pg8::gemm_phase<EpiSwiGLU, pg8::StaticOrder, true, true>(lds, g, S, E, wave);
        }
        GRID_BAR();
        {
            PHASE_IDS();
            pg8::Gemm g{WSP(WS_HID), WSP(WS_W + (size_t)l * LW_END + LW_W2B), MT, DM, DFF}; pg8::StaticOrder S; S.init(MT, DM, G, bx);
            EpiResid E{out + O_YP, out + O_YS, out, 0.5f};
            pg8::gemm_phase<EpiResid, pg8::StaticOrder, true, true>(lds, g, S, E, wave);
        }
        if (l + 1 < DEPTH) {
            GRID_BAR();
            { PHASE_IDS(); for (int m = gw; m < MT; m += NGW) rms_row_to_bf16(out + (size_t)m * DM, AIN(I_NFF1) + (size_t)(l + 1) * DM, WSP(WS_H) + (size_t)m * DM, lane); }
            GRID_BAR();
        }
    }
}

extern "C" void kernel_launch(void* const* d_in, const int* in_sizes, int n_in, void* d_out, int out_size, void* d_ws, size_t ws_size, hipStream_t stream) {
    static int grid = 0;
    if (grid == 0) {
        if (n_in != 23 || (size_t)out_size != O_END || ws_size < WS_END) { fprintf(stderr, "kernel_launch: unexpected shapes (n_in %d out %d ws %zu)\n", n_in, out_size, ws_size); grid = -1; return; }
        int dev = 0, cus = 0;
        if (hipGetDevice(&dev) != hipSuccess || hipDeviceGetAttribute(&cus, hipDeviceAttributeMultiprocessorCount, dev) != hipSuccess) { grid = -1; return; }
        if (hipFuncSetAttribute((const void*)enc_fwd, hipFuncAttributeMaxDynamicSharedMemorySize, LDS_BYTES) != hipSuccess) { fprintf(stderr, "kernel_launch: hipFuncSetAttribute failed\n"); grid = -1; return; }
        int per_cu = 0;
        if (hipOccupancyMaxActiveBlocksPerMultiprocessor(&per_cu, (const void*)enc_fwd, NWAVES * 64, LDS_BYTES) != hipSuccess || per_cu < 1) fprintf(stderr, "kernel_launch: occupancy query reports %d\n", per_cu);
        (void)hipGetLastError();
        grid = cus;
    }
    if (grid < 0) return;
    if (hipMemsetAsync((char*)d_ws + WS_CTL, 0, CTL_ZERO_BYTES, stream) != hipSuccess) return;
    Args a{};
    for (int i = 0; i < 23; ++i) a.in[i] = (const float*)d_in[i];
    a.out = (float*)d_out; a.ws = (unsigned char*)d_ws;
    hipLaunchKernelGGL(enc_fwd, dim3(grid), dim3(NWAVES * 64), LDS_BYTES, stream, a);
}
```

```cpp
#include <hip/hip_runtime.h>
#include <cstdio>
#include <cstdint>

__device__ __forceinline__ int lane_id_opaque() { int l; asm volatile("v_mbcnt_lo_u32_b32 %0, -1, 0\n\tv_mbcnt_hi_u32_b32 %0, -1, %0" : "=v"(l)); return l; }
template <int M> __device__ __forceinline__ float swz_xor(float v) { return __int_as_float(__builtin_amdgcn_ds_swizzle(__float_as_int(v), (M << 10) | 0x1f)); }

namespace pg8 {
#define PG8_LAS __attribute__((address_space(3)))
typedef unsigned short bf16_t;
typedef short bf16x8 __attribute__((ext_vector_type(8)));
typedef float f32x4 __attribute__((ext_vector_type(4)));
typedef unsigned u32x4 __attribute__((ext_vector_type(4)));
constexpr int BM = 256, BK = 64, HALF = 128, HTB = HALF * BK * 2  , STAGE_BYTES = 8 * HTB, NXCD = 8, WGM = 8;

__host__ __device__ __forceinline__ int lds_byte(int r, int c) { const int st = (r >> 4) * 2 + (c >> 5), rr = r & 15, cc = c & 31, ob = rr * 64 + cc * 2; return st * 1024 + (ob ^ (((ob >> 9) & 1) << 5)); }
__host__ __device__ __forceinline__ void stage_rc(int b, int& R, int& C) { const int st = b / 1024, sb = b % 1024, swz = sb ^ (((sb >> 9) & 1) << 5); R = (st >> 1) * 16 + swz / 64; C = (st & 1) * 32 + (swz % 64) / 2; }
__host__ __device__ __forceinline__ int perm32(int rho) { const int n = rho >> 4, i = rho & 15; return 8 * (i >> 2) + 4 * n + (i & 3); }

struct Unit { int pm, pn, k0, nt; };
struct Gemm { const bf16_t* A; const bf16_t* Bt; int M, N, K; };

struct StaticOrder {
    int nM, nN, nwg, G, c;
    __host__ __device__ void init(int M, int N, int K, int G_, int c_) { nM = M / BM; nN = N / BM; nwg = nM * nN; G = G_; c = c_; ntk = K / BK; }
    __host__ __device__ bool next(int i, Unit& u) const {
        const long L = (long)i * G + c; if (L >= nwg) return false;
        int wgid = (int)L; { const int q = nwg / NXCD, r = nwg % NXCD, xcd = wgid % NXCD, off = wgid / NXCD; wgid = (xcd < r ? xcd * (q + 1) : r * (q + 1) + (xcd - r) * q) + off; }
        const int nig = WGM * nN, gid = wgid / nig, fm = gid * WGM, gsz = (nM - fm) < WGM ? (nM - fm) : WGM;
        u.pm = fm + ((wgid % nig) % gsz); u.pn = (wgid % nig) / gsz; u.k0 = 0; u.nt = ntk; return true;
    }
    int ntk;
    __device__ __forceinline__ void a_ready(const Unit&) const {}
    __device__ __forceinline__ void done(const Unit&) const {}
};
struct SplitOrder {
    int nitem, c, cpu, tpc, nt_total, pm;
    __device__ bool next(int i, Unit& u) const { if (i > 0 || c >= nitem) return false; const int kc = c % cpu; u.pm = pm; u.pn = c / cpu; u.k0 = kc * tpc; u.nt = (kc == cpu - 1) ? nt_total - kc * tpc : tpc; return true; }
    __device__ __forceinline__ void a_ready(const Unit&) const {}
    __device__ __forceinline__ void done(const Unit&) const {}
};

__device__ __forceinline__ unsigned cvt_pk_bf16(float lo, float hi) { unsigned r; asm volatile("v_cvt_pk_bf16_f32 %0, %1, %2" : "=v"(r) : "v"(lo), "v"(hi)); return r; }

template <class Epi, class Sched, bool ALIGN_EPI = false, bool SP2 = false>
__device__ __forceinline__ void gemm_phase(PG8_LAS unsigned char* lds, const Gemm g, const Sched& S, const Epi& E, const int wid) {
    const int lane = lane_id_opaque();
    const int tid = wid * 64 + lane, wr = wid >> 2, wc = wid & 3, fr = lane & 15, fq = lane >> 4;
    const int K = g.K;
    unsigned voffA[2], voffB[2];
#pragma unroll
    for (int i = 0; i < 2; ++i) { int R, C; stage_rc(tid * 16 + i * 8192, R, C); const int Rb = Epi::PERM ? ((R & ~31) + perm32(R & 31)) : R;
        voffA[i] = (unsigned)(R * K + C) * 2u; voffB[i] = (unsigned)(Rb * K + C) * 2u; }
    const size_t kstep = (size_t)(BK * 2);
    const size_t hstep = (size_t)HALF * K * 2;
    const size_t tstep = 2 * hstep;
    const unsigned ldsw = (unsigned)wid * 1024u;
    const int aoff = lds_byte(wr * 64 + fr, fq * 8), boff = lds_byte(wc * 32 + fr, fq * 8);
#define PG8_SA(b, h) (((b) * 2 + (h)) * HTB)
#define PG8_SB(b, h) ((4 + (b) * 2 + (h)) * HTB)
#define PG8_STAGE(bufoff, gbase, voff) do { _Pragma("unroll") for (int _i = 0; _i < 2; ++_i) \
        __builtin_amdgcn_global_load_lds((const unsigned*)((const char*)(gbase) + (voff)[_i]), (PG8_LAS unsigned*)(lds + (bufoff) + ldsw + _i * 8192), 16, 0, 0); } while (0)
#define PG8_LDA(dst, b, h) do { _Pragma("unroll") for (int m = 0; m < 4; ++m) _Pragma("unroll") for (int k = 0; k < 2; ++k) dst[m][k] = *(const PG8_LAS bf16x8*)(lds + PG8_SA(b, h) + aoff + m * 2048 + k * 1024); } while (0)
#define PG8_LDB(dst, b, h) do { _Pragma("unroll") for (int n = 0; n < 2; ++n) _Pragma("unroll") for (int k = 0; k < 2; ++k) dst[n][k] = *(const PG8_LAS bf16x8*)(lds + PG8_SB(b, h) + boff + n * 2048 + k * 1024); } while (0)
#define PG8_MMA(ai, bj, At, Bt) do { __builtin_amdgcn_s_setprio(1); _Pragma("unroll") for (int m = 0; m < 4; ++m) _Pragma("unroll") for (int n = 0; n < 2; ++n) _Pragma("unroll") for (int k = 0; k < 2; ++k) \
        acc[ai][bj][m][n] = __builtin_amdgcn_mfma_f32_16x16x32_bf16(Bt[n][k], At[m][k], acc[ai][bj][m][n], 0, 0, 0); __builtin_amdgcn_s_setprio(0); } while (0)
#define PG8_WAIT_V(n) asm volatile("s_waitcnt vmcnt(" #n ")" ::: "memory")
#define PG8_WAIT_L(n) asm volatile("s_waitcnt lgkmcnt(" #n ")" ::: "memory")
#define PG8_BAR __builtin_amdgcn_s_barrier()
#define PG8_SCHED __builtin_amdgcn_sched_barrier(0)
    Unit cur, nxt; int ui = 0;
    if (!S.next(0, cur)) return;
    f32x4 acc[2][2][4][2];
#pragma unroll
    for (int a = 0; a < 2; ++a)
#pragma unroll
        for (int b = 0; b < 2; ++b)
#pragma unroll
            for (int m = 0; m < 4; ++m)
#pragma unroll
                for (int n = 0; n < 2; ++n) acc[a][b][m][n] = (f32x4){0.f, 0.f, 0.f, 0.f};
    bf16x8 At[4][2], B0[2][2], B1[2][2];
    const char* cA = (const char*)g.A + (size_t)cur.pm * tstep + (size_t)cur.k0 * kstep; const char* cB = (const char*)g.Bt + (size_t)cur.pn * tstep + (size_t)cur.k0 * kstep;
    S.a_ready(cur);
    if constexpr (SP2) {
        PG8_STAGE(PG8_SB(0, 0), cB, voffB); PG8_STAGE(PG8_SB(0, 1), cB + hstep, voffB); PG8_STAGE(PG8_SA(0, 0), cA, voffA); PG8_STAGE(PG8_SA(0, 1), cA + hstep, voffA);
        if (wr == 1) PG8_BAR;
        PG8_WAIT_V(2); PG8_BAR;
        PG8_STAGE(PG8_SB(1, 0), cB + kstep, voffB); PG8_STAGE(PG8_SA(1, 0), cA + kstep, voffA); PG8_STAGE(PG8_SB(1, 1), cB + hstep + kstep, voffB);
        PG8_WAIT_V(6); PG8_BAR;
    } else {
        PG8_STAGE(PG8_SB(0, 0), cB, voffB); PG8_STAGE(PG8_SA(0, 0), cA, voffA); PG8_STAGE(PG8_SB(0, 1), cB + hstep, voffB); PG8_STAGE(PG8_SA(0, 1), cA + hstep, voffA);
        if (wr == 1) PG8_BAR;
        PG8_WAIT_V(4); PG8_BAR;
        PG8_STAGE(PG8_SB(1, 0), cB + kstep, voffB); PG8_STAGE(PG8_SA(1, 0), cA + kstep, voffA); PG8_STAGE(PG8_SB(1, 1), cB + hstep + kstep, voffB);
        PG8_WAIT_V(6); PG8_BAR;
    }
    for (;;) {
        const bool has_next = S.next(ui + 1, nxt);
        const char* nA = has_next ? (const char*)g.A + (size_t)nxt.pm * tstep + (size_t)nxt.k0 * kstep : cA; const char* nB = has_next ? (const char*)g.Bt + (size_t)nxt.pn * tstep + (size_t)nxt.k0 * kstep : cB;
        const int nt = cur.nt;
        for (int t = 0; t < nt; t += 2) {
            const bool last = (t == nt - 2);
            const char* a1 = cA + (size_t)(t + 1) * kstep;
            const char* a2 = last ? nA : cA + (size_t)(t + 2) * kstep; const char* b2 = last ? nB : cB + (size_t)(t + 2) * kstep;
            const char* a3 = a2 + kstep; const char* b3 = b2 + kstep;
            if (last && has_next) S.a_ready(nxt);
            if constexpr (SP2) {
            PG8_LDB(B0, 0, 0); PG8_LDB(B1, 0, 1); PG8_SCHED; PG8_LDA(At, 0, 0); PG8_STAGE(PG8_SA(1, 1), a1 + hstep, voffA);
            PG8_WAIT_V(8); PG8_WAIT_L(0); PG8_BAR; PG8_MMA(0, 0, At, B0); PG8_MMA(0, 1, At, B1); PG8_BAR; PG8_SCHED;
            PG8_LDA(At, 0, 1); PG8_STAGE(PG8_SB(0, 0), b2, voffB); PG8_STAGE(PG8_SB(0, 1), b2 + hstep, voffB); PG8_STAGE(PG8_SA(0, 0), a2, voffA);
            PG8_WAIT_V(8); PG8_WAIT_L(0); PG8_BAR; PG8_MMA(1, 0, At, B0); PG8_MMA(1, 1, At, B1); PG8_BAR; PG8_SCHED;
            PG8_LDB(B0, 1, 0); PG8_LDB(B1, 1, 1); PG8_SCHED; PG8_LDA(At, 1, 0); PG8_STAGE(PG8_SA(0, 1), a2 + hstep, voffA);
            PG8_WAIT_V(8); PG8_WAIT_L(0); PG8_BAR; PG8_MMA(0, 0, At, B0); PG8_MMA(0, 1, At, B1); PG8_BAR; PG8_SCHED;
            PG8_LDA(At, 1, 1); PG8_STAGE(PG8_SB(1, 0), b3, voffB); PG8_STAGE(PG8_SB(1, 1), b3 + hstep, voffB); PG8_STAGE(PG8_SA(1, 0), a3, voffA);
            PG8_WAIT_V(8); PG8_WAIT_L(0); PG8_BAR; PG8_MMA(1, 0, At, B0); PG8_MMA(1, 1, At, B1); PG8_BAR; PG8_SCHED;
            } else {
            PG8_LDB(B0, 0, 0); PG8_SCHED; PG8_LDA(At, 0, 0); PG8_STAGE(PG8_SA(1, 1), a1 + hstep, voffA);
            PG8_WAIT_L(8); PG8_BAR; PG8_WAIT_L(0); PG8_MMA(0, 0, At, B0); PG8_BAR; PG8_SCHED;
            PG8_LDB(B1, 0, 1); PG8_STAGE(PG8_SB(0, 0), b2, voffB);
            PG8_BAR; PG8_WAIT_L(0); PG8_MMA(0, 1, At, B1); PG8_BAR;
            PG8_LDA(At, 0, 1); PG8_STAGE(PG8_SA(0, 0), a2, voffA);
            PG8_BAR; PG8_WAIT_L(0); PG8_MMA(1, 0, At, B0); PG8_BAR; PG8_SCHED;
            PG8_STAGE(PG8_SB(0, 1), b2 + hstep, voffB);
            PG8_WAIT_V(6); PG8_BAR; PG8_MMA(1, 1, At, B1); PG8_BAR;
            PG8_LDB(B0, 1, 0); PG8_SCHED; PG8_LDA(At, 1, 0); PG8_STAGE(PG8_SA(0, 1), a2 + hstep, voffA);
            PG8_WAIT_L(8); PG8_BAR; PG8_WAIT_L(0); PG8_MMA(0, 0, At, B0); PG8_BAR; PG8_SCHED;
            PG8_LDB(B1, 1, 1); PG8_STAGE(PG8_SB(1, 0), b3, voffB);
            PG8_BAR; PG8_WAIT_L(0); PG8_MMA(0, 1, At, B1); PG8_BAR;
            PG8_LDA(At, 1, 1); PG8_STAGE(PG8_SA(1, 0), a3, voffA);
            PG8_BAR; PG8_WAIT_L(0); PG8_MMA(1, 0, At, B0); PG8_BAR; PG8_SCHED;
            PG8_STAGE(PG8_SB(1, 1), b3 + hstep, voffB);
            PG8_WAIT_V(6); PG8_BAR; PG8_MMA(1, 1, At, B1); PG8_BAR;
            }
        }
        if constexpr (ALIGN_EPI) { if (wr == 0) PG8_BAR; }
        E(acc, cur, wr, wc, fr, fq); S.done(cur);
        if (!has_next) break;
#pragma unroll
        for (int a = 0; a < 2; ++a)
#pragma unroll
            for (int b = 0; b < 2; ++b)
#pragma unroll
                for (int m = 0; m < 4; ++m)
#pragma unroll
                    for (int n = 0; n < 2; ++n) acc[a][b][m][n] = (f32x4){0.f, 0.f, 0.f, 0.f};
        cur = nxt; cA = nA; cB = nB; ++ui;
        if constexpr (ALIGN_EPI) { if (wr == 1) PG8_BAR; }
    }
    PG8_WAIT_V(0);
    if constexpr (!ALIGN_EPI) { if (wr == 0) PG8_BAR; }
    PG8_BAR;
#undef PG8_SA
#undef PG8_SB
#undef PG8_STAGE
#undef PG8_LDA
#undef PG8_LDB
#undef PG8_MMA
#undef PG8_WAIT_V
#undef PG8_WAIT_L
#undef PG8_BAR
#undef PG8_SCHED
}
}

constexpr int DM = 2048, NBATCH = 8, SEQ = 4096, DEPTH = 4, SBATCH = 8, SSEQ = 32, PAST = 1024;
constexpr int HD = 128, NMEM = 256;
constexpr int INC = 3584, DFF = 5504, MIXW = 2048;
constexpr int MP = NBATCH * SEQ, MS = SBATCH * SSEQ, MT = MP + MS;
constexpr int MMEM = NBATCH * NMEM;
constexpr int C_QA = 0, C_KA = 1024, C_VA = 1280, C_QB = 1536, C_KB = 2048, C_VB = 2560, C_QM = 3072;
constexpr float EPS = 1e-6f;
constexpr float LOG2E = 1.4426950408889634f;

constexpr size_t O_YP = 0;
constexpr size_t O_YS = O_YP + (size_t)MP * DM;
constexpr size_t O_AKP = O_YS + (size_t)MS * DM;
constexpr size_t O_AVP = O_AKP + (size_t)DEPTH * NBATCH * 128 * 2 * HD;
constexpr size_t O_BKP = O_AVP + (size_t)DEPTH * NBATCH * 128 * 2 * HD;
constexpr size_t O_BVP = O_BKP + (size_t)DEPTH * NBATCH * 512 * 4 * HD;
constexpr size_t O_MKP = O_BVP + (size_t)DEPTH * NBATCH * 512 * 4 * HD;
constexpr size_t O_MVP = O_MKP + (size_t)DEPTH * NBATCH * NMEM * 4 * HD;
constexpr size_t O_AKS = O_MVP + (size_t)DEPTH * NBATCH * NMEM * 4 * HD;
constexpr size_t O_AVS = O_AKS + (size_t)DEPTH * SBATCH * SSEQ * 2 * HD;
constexpr size_t O_BKS = O_AVS + (size_t)DEPTH * SBATCH * SSEQ * 2 * HD;
constexpr size_t O_BVS = O_BKS + (size_t)DEPTH * SBATCH * SSEQ * 4 * HD;
constexpr size_t O_END = O_BVS + (size_t)DEPTH * SBATCH * SSEQ * 4 * HD;
static_assert(O_END == 96468992, "output size");

constexpr size_t MiB = 1u << 20;
constexpr size_t WS_CTL = 0, CTL_ZERO_BYTES = 1 * MiB;
constexpr size_t SZ_W1A = (size_t)2 * DFF * DM * 2, SZ_W1B = (size_t)DM * DFF * 2, SZ_WIN = (size_t)INC * DM * 2, SZ_WOUT = (size_t)DM * MIXW * 2;
constexpr size_t LW_W1A = 0, LW_W1B = LW_W1A + SZ_W1A, LW_WIN = LW_W1B + SZ_W1B, LW_WOUT = LW_WIN + SZ_WIN, LW_W2A = LW_WOUT + SZ_WOUT, LW_W2B = LW_W2A + SZ_W1A, LW_END = LW_W2B + SZ_W1B;
constexpr size_t WS_W = 2 * MiB;
constexpr size_t WS_WMEM = WS_W + DEPTH * LW_END;
constexpr size_t WS_H = WS_WMEM + (size_t)DEPTH * 1024 * DM * 2;
constexpr size_t WS_AMEM = WS_H + (size_t)MT * DM * 2;
constexpr size_t WS_MKB = WS_AMEM + (size_t)MMEM * DM * 2;
constexpr size_t WS_MVB = WS_MKB + (size_t)DEPTH * MMEM * 512 * 2;
constexpr size_t WS_CAK = WS_MVB + (size_t)DEPTH * MMEM * 512 * 2;
constexpr size_t N_CA = (size_t)DEPTH * SBATCH * 128 * 2 * HD, N_CB = (size_t)DEPTH * SBATCH * 512 * 4 * HD, N_CM = (size_t)DEPTH * SBATCH * NMEM * 4 * HD;
constexpr size_t WS_CAV = WS_CAK + N_CA * 2, WS_CBK = WS_CAV + N_CA * 2, WS_CBV = WS_CBK + N_CB * 2, WS_CMK = WS_CBV + N_CB * 2, WS_CMV = WS_CMK + N_CM * 2;
constexpr size_t WS_HID = WS_CMV + N_CM * 2;
constexpr size_t WS_PROJ = WS_HID, WS_OB = WS_PROJ + (size_t)MT * INC * 2;
constexpr size_t SZ_HID = (size_t)MT * DFF * 2, SZ_PO = (size_t)MT * INC * 2 + (size_t)MT * DM * 2;
constexpr size_t WS_PART = WS_HID + (SZ_HID > SZ_PO ? SZ_HID : SZ_PO);
constexpr size_t WS_RSTD = WS_PART + (size_t)MP * 32 * 4;
constexpr size_t WS_PARTX = WS_RSTD + (((size_t)MT * 4 + 255) / 256) * 256;
constexpr int NKC_FF = 21, NKC_OUT = 8, TPC = 4;
constexpr size_t WS_END = WS_PARTX + (size_t)NKC_FF * MS * DM * 4;
static_assert(WS_END < (size_t)1400 * MiB, "workspace budget");
static_assert(WS_W % 256 == 0 && LW_END % 256 == 0 && WS_H % 256 == 0 && WS_HID % 256 == 0 && WS_OB % 256 == 0, "alignment");

constexpr int CW_BAR = 4096;
constexpr int RING_BYTES = 131072, LDSCTL_OFF = RING_BYTES, MISC_OFF = LDSCTL_OFF + 320, LDS_BYTES = 147456;
constexpr int NWAVES = 8;

#define GAS __attribute__((address_space(1)))
#define LAS __attribute__((address_space(3)))
typedef unsigned short bf16;
typedef unsigned v4u __attribute__((ext_vector_type(4)));
typedef float f32x4 __attribute__((ext_vector_type(4)));
typedef short bf16x8 __attribute__((ext_vector_type(8)));
#define LDS_WAIT() asm volatile("s_waitcnt lgkmcnt(0)" ::: "memory")
#define VM_WAIT() asm volatile("s_waitcnt vmcnt(0)" ::: "memory")
__device__ __forceinline__ unsigned pk2(float lo, float hi) { return pg8::cvt_pk_bf16(lo, hi); }
__device__ __forceinline__ float bf_lo(unsigned w) { return __uint_as_float(w << 16); }
__device__ __forceinline__ float bf_hi(unsigned w) { return __uint_as_float(w & 0xffff0000u); }

#define XB_TMO      128
#define XB_XCNT(j)  (256  + 64 * (j))
#define XB_XSUB(j)  (1280 + 64 * (j))
#define XB_XGEN(j)  (2304 + 64 * (j))
#define XB_TOP      3328
#define XB_TOPGEN   3392
#define XCD_BAR_WORDS 3456
#define XB_SPIN_CAP (1u << 18)
__device__ __forceinline__ unsigned xb_ld(unsigned* p)              { return __hip_atomic_load(p, __ATOMIC_RELAXED, __HIP_MEMORY_SCOPE_AGENT); }
__device__ __forceinline__ unsigned xb_add(unsigned* p, unsigned v) { return __hip_atomic_fetch_add(p, v, __ATOMIC_RELAXED, __HIP_MEMORY_SCOPE_AGENT); }
__device__ __forceinline__ unsigned xb_xcc_id() { return (unsigned)__builtin_amdgcn_s_getreg((3 << 11) | 20) & 0xFu; }
#define XB_SPIN(cond, bar) do { unsigned _sp = 0; while (cond) { __builtin_amdgcn_s_sleep(1); \
    if ((++_sp & 255u) == 0u) { if (xb_ld(&(bar)[XB_TMO])) break; if (_sp > XB_SPIN_CAP) { atomicAdd(&(bar)[XB_TMO], 1u); break; } } } } while (0)
struct XcdBarrier { unsigned* bar; unsigned x; volatile LAS unsigned* st; };
__device__ __forceinline__ XcdBarrier xcd_barrier_post(unsigned* bar, volatile LAS unsigned* st) {
    XcdBarrier b; b.bar = bar; b.x = xb_xcc_id(); b.st = st;
    if (threadIdx.x == 0) (void)xb_add(&bar[XB_XCNT(b.x)], 1u);
    return b;
}
__device__ __forceinline__ void xcd_barrier_complete(unsigned* bar, unsigned x, unsigned& nloc, unsigned& nx) {
    const unsigned G = gridDim.x * gridDim.y * gridDim.z;
    unsigned sum, cnt, mine, sp = 0u;
    for (;;) {
        sum = 0u; cnt = 0u; mine = 0u;
#pragma unroll
        for (unsigned j = 0; j < 16; ++j) { const unsigned c = xb_ld(&bar[XB_XCNT(j)]); sum += c; cnt += (c > 0u) ? 1u : 0u; mine = (j == x) ? c : mine; }
        if (sum == G) break;
        __builtin_amdgcn_s_sleep(1);
        if ((++sp & 255u) == 0u) { if (xb_ld(&bar[XB_TMO])) break; if (sp > XB_SPIN_CAP) { atomicAdd(&bar[XB_TMO], 1u); break; } }
    }
    nloc = mine > 0u ? mine : 1u; nx = cnt > 0u ? cnt : 1u;
}
__device__ __forceinline__ void xcd_barrier(const XcdBarrier& b) {
    asm volatile("s_waitcnt vmcnt(0)" ::: "memory");
    __syncthreads();
    if (threadIdx.x == 0) {
        unsigned* bar = b.bar;
        __builtin_amdgcn_s_waitcnt(0);
        unsigned nloc = b.st[0], nx = b.st[1];
        if (nloc == 0u) { xcd_barrier_complete(bar, b.x, nloc, nx); b.st[0] = nloc; b.st[1] = nx; }
        const unsigned old = xb_add(&bar[XB_XSUB(b.x)], 1u);
        const unsigned gen = old / nloc;
        if (old + 1u == (gen + 1u) * nloc) {
            __builtin_amdgcn_fence(__ATOMIC_RELEASE, "agent");
            asm volatile("s_waitcnt vmcnt(0)" ::: "memory");
            const unsigned og = xb_add(&bar[XB_TOP], 1u);
            const unsigned tg = og / nx;
            if (og + 1u == (tg + 1u) * nx) xb_add(&bar[XB_TOPGEN], 1u);
            else XB_SPIN(xb_ld(&bar[XB_TOPGEN]) == tg, bar);
            __builtin_amdgcn_fence(__ATOMIC_ACQUIRE, "agent");
            xb_add(&bar[XB_XGEN(b.x)], 1u);
            asm volatile("s_waitcnt vmcnt(0)" ::: "memory");
        } else {
            XB_SPIN(xb_ld(&bar[XB_XGEN(b.x)]) == gen, bar);
            __builtin_amdgcn_fence(__ATOMIC_ACQUIRE, "agent");
            asm volatile("s_waitcnt vmcnt(0)" ::: "memory");
        }
    }
    __syncthreads();
}

struct EpiSwiGLU {
    static constexpr bool PERM = true, AFTER_DRAIN = false;
    bf16* O; const float* rstd;
    __device__ __forceinline__ void operator()(const pg8::f32x4 (&acc)[2][2][4][2], const pg8::Unit& u, int wr, int wc, int fr, int fq) const {
        asm volatile("" : "+v"(fr), "+v"(fq));
        const int row0 = u.pm * 256 + wr * 64 + fr, col0 = u.pn * 128 + wc * 32 + 8 * fq;
        float rs[2][4];
#pragma unroll
        for (int ai = 0; ai < 2; ++ai)
#pragma unroll
            for (int m = 0; m < 4; ++m) rs[ai][m] = rstd[row0 + ai * 128 + m * 16];
#pragma unroll
        for (int ai = 0; ai < 2; ++ai)
#pragma unroll
            for (int m = 0; m < 4; ++m) {
                bf16* rowp = O + (size_t)(row0 + ai * 128 + m * 16) * DFF + col0;
                const float r = rs[ai][m];
                float h[8];
#pragma unroll
                for (int n = 0; n < 2; ++n)
#pragma unroll
                    for (int j = 0; j < 4; ++j) { const float g = acc[ai][0][m][n][j] * r, up = acc[ai][1][m][n][j] * r;
                        const float e = __builtin_amdgcn_exp2f(-g * LOG2E); h[n * 4 + j] = g * __builtin_amdgcn_rcpf(1.0f + e) * up; }
                v4u w; w.x = pk2(h[0], h[1]); w.y = pk2(h[2], h[3]); w.z = pk2(h[4], h[5]); w.w = pk2(h[6], h[7]);
                *(v4u*)rowp = w; }
    }
};
struct EpiResidP {
    static constexpr bool PERM = false, AFTER_DRAIN = false;
    const float* res; float* dst; bf16* xb; float* part; float scale;
    __device__ __forceinline__ void operator()(const pg8::f32x4 (&acc)[2][2][4][2], const pg8::Unit& u, int wr, int wc, int fr, int fq) const {
        asm volatile("" : "+v"(fr), "+v"(fq));
        const int rloc = wr * 64 + fr, col0 = u.pn * 256 + wc * 32 + 4 * fq;
        const float* rb = res + (size_t)u.pm * 256 * DM; float* db = dst + (size_t)u.pm * 256 * DM; bf16* xp = xb + (size_t)u.pm * 256 * DM;
        float* pp = part + (size_t)u.pm * 256 * 32 + u.pn * 4 + wc;
#pragma unroll
        for (int ai = 0; ai < 2; ++ai) {
            f32x4 r[4][4];
#pragma unroll
            for (int m = 0; m < 4; ++m)
#pragma unroll
                for (int q = 0; q < 4; ++q) r[m][q] = *(const f32x4*)(rb + (size_t)(rloc + ai * 128 + m * 16) * DM + col0 + (q >> 1) * 128 + (q & 1) * 16);
#pragma unroll
            for (int m = 0; m < 4; ++m) { const size_t off = (size_t)(rloc + ai * 128 + m * 16) * DM + col0; float ss = 0.f;
#pragma unroll
                for (int q = 0; q < 4; ++q) { const f32x4 v = r[m][q] + acc[ai][q >> 1][m][q & 1] * scale; const int co = (q >> 1) * 128 + (q & 1) * 16;
                    *(f32x4*)(db + off + co) = v; ss += (v.x * v.x + v.y * v.y) + (v.z * v.z + v.w * v.w);
                    *(unsigned long long*)(xp + off + co) = (unsigned long long)pk2(v.x, v.y) | ((unsigned long long)pk2(v.z, v.w) << 32); }
                ss += swz_xor<16>(ss);
                { auto rr = __builtin_amdgcn_permlane32_swap(__float_as_uint(ss), __float_as_uint(ss), false, false); ss = __uint_as_float(rr[0]) + __uint_as_float(rr[1]); }
                if (fq == 0) pp[(size_t)(rloc + ai * 128 + m * 16) * 32] = ss; }
            asm volatile("" ::: "memory"); }
    }
};
struct EpiPartial {
    static constexpr bool PERM = false, AFTER_DRAIN = false;
    float* px;
    __device__ __forceinline__ void operator()(const pg8::f32x4 (&acc)[2][2][4][2], const pg8::Unit& u, int wr, int wc, int fr, int fq) const {
        asm volatile("" : "+v"(fr), "+v"(fq));
        const int rloc = wr * 64 + fr, col0 = u.pn * 256 + wc * 32 + 4 * fq;
        float* db = px + (size_t)(u.k0 / TPC) * MS * DM;
#pragma unroll
        for (int ai = 0; ai < 2; ++ai)
#pragma unroll
            for (int m = 0; m < 4; ++m) { float* rowp = db + (size_t)(rloc + ai * 128 + m * 16) * DM + col0;
#pragma unroll
                for (int bj = 0; bj < 2; ++bj)
#pragma unroll
                    for (int n = 0; n < 2; ++n) *(f32x4*)(rowp + bj * 128 + n * 16) = acc[ai][bj][m][n]; }
    }
};
struct EpiProj {
    static constexpr bool PERM = true, AFTER_DRAIN = false;
    bf16* O; const float* rstd;
    __device__ __forceinline__ void operator()(const pg8::f32x4 (&acc)[2][2][4][2], const pg8::Unit& u, int wr, int wc, int fr, int fq) const {
        asm volatile("" : "+v"(fr), "+v"(fq));
        const int row0 = u.pm * 256 + wr * 64 + fr, col0 = u.pn * 256 + wc * 32 + 8 * fq;
        float rs[2][4];
#pragma unroll
        for (int ai = 0; ai < 2; ++ai)
#pragma unroll
            for (int m = 0; m < 4; ++m) rs[ai][m] = rstd[row0 + ai * 128 + m * 16];
#pragma unroll
        for (int ai = 0; ai < 2; ++ai)
#pragma unroll
            for (int m = 0; m < 4; ++m) { bf16* rowp = O + (size_t)(row0 + ai * 128 + m * 16) * INC + col0; const float r = rs[ai][m];
#pragma unroll
                for (int bj = 0; bj < 2; ++bj) { const f32x4 v0 = acc[ai][bj][m][0] * r, v1 = acc[ai][bj][m][1] * r;
                    v4u w; w.x = pk2(v0[0], v0[1]); w.y = pk2(v0[2], v0[3]); w.z = pk2(v1[0], v1[1]); w.w = pk2(v1[2], v1[3]);
                    *(v4u*)(rowp + bj * 128) = w; } }
    }
};
struct EpiMem {
    static constexpr bool PERM = false, AFTER_DRAIN = false;
    float* outK;
    __device__ __forceinline__ void operator()(const pg8::f32x4 (&acc)[2][2][4][2], const pg8::Unit& u, int wr, int wc, int fr, int fq) const {
        asm volatile("" : "+v"(fr), "+v"(fq));
        const int l = u.pn >> 2, part = (u.pn >> 1) & 1, half = u.pn & 1;
        float* base = outK + (size_t)part * (O_MVP - O_MKP) + (size_t)l * MMEM * 512 + (size_t)u.pm * 256 * 512;
        const int rloc = wr * 64 + fr, col0 = half * 256 + wc * 32 + 4 * fq;
#pragma unroll
        for (int ai = 0; ai < 2; ++ai)
#pragma unroll
            for (int m = 0; m < 4; ++m) { float* rowp = base + (size_t)(rloc + ai * 128 + m * 16) * 512 + col0;
#pragma unroll
                for (int bj = 0; bj < 2; ++bj)
#pragma unroll
                    for (int n = 0; n < 2; ++n) *(f32x4*)(rowp + bj * 128 + n * 16) = acc[ai][bj][m][n]; }
    }
};

__device__ __forceinline__ float wave_sum(float v) {
    v += swz_xor<1>(v); v += swz_xor<2>(v); v += swz_xor<4>(v); v += swz_xor<8>(v); v += swz_xor<16>(v);
    auto rr = __builtin_amdgcn_permlane32_swap(__float_as_uint(v), __float_as_uint(v), false, false);
    return __uint_as_float(rr[0]) + __uint_as_float(rr[1]);
}
__device__ __forceinline__ float sum16(float v) {
    v += swz_xor<1>(v); v += swz_xor<2>(v); v += swz_xor<4>(v); v += swz_xor<8>(v); return v;
}
__device__ __forceinline__ void tr_item(const float* W, int N, int K, bf16* WT, int k0, int nsrc0, int ndst0, const float* gs, LAS float* scr, int lane) {
#pragma unroll 8
    for (int i = 0; i < 32; ++i) { const int kk = 2 * i + (lane >> 5); float v = W[(size_t)(k0 + kk) * N + nsrc0 + (lane & 31)]; if (gs) v *= gs[k0 + kk]; scr[kk * 33 + (lane & 31)] = v; }
    LDS_WAIT(); asm volatile("" ::: "memory");
    const int c = lane & 7;
#pragma unroll
    for (int j = 0; j < 4; ++j) { const int n = (lane >> 3) + 8 * j; const LAS float* s = scr + (8 * c) * 33 + n;
        v4u o; o.x = pk2(s[0 * 33], s[1 * 33]); o.y = pk2(s[2 * 33], s[3 * 33]); o.z = pk2(s[4 * 33], s[5 * 33]); o.w = pk2(s[6 * 33], s[7 * 33]);
        *(GAS v4u*)(WT + (size_t)(ndst0 + n) * K + k0 + 8 * c) = o; }
    LDS_WAIT(); asm volatile("" ::: "memory");
}
__device__ __forceinline__ void rms_row_to_bf16(const float* xrow, const float* g, bf16* orow, int lane) {
    const GAS f32x4* xr = (const GAS f32x4*)xrow + lane;
    f32x4 v[8]; float s = 0.f;
#pragma unroll
    for (int j = 0; j < 8; ++j) { v[j] = xr[64 * j]; s += (v[j].x * v[j].x + v[j].y * v[j].y) + (v[j].z * v[j].z + v[j].w * v[j].w); }
    const float rstd = 1.0f / sqrtf(wave_sum(s) * (1.f / DM) + EPS);
    GAS unsigned long long* o8 = (GAS unsigned long long*)orow + lane;
#pragma unroll
    for (int j = 0; j < 8; ++j) { f32x4 gg = (f32x4){1.f, 1.f, 1.f, 1.f}; if (g) gg = ((const GAS f32x4*)g)[lane + 64 * j];
        o8[64 * j] = (unsigned long long)pk2(v[j].x * rstd * gg.x, v[j].y * rstd * gg.y) | ((unsigned long long)pk2(v[j].z * rstd * gg.z, v[j].w * rstd * gg.w) << 32); }
}

__device__ __forceinline__ void row_to_bf16_rstd(const float* xrow, bf16* orow, float* rstd_out, int lane) {
    const GAS f32x4* xr = (const GAS f32x4*)xrow + lane;
    f32x4 v[8]; float s = 0.f;
#pragma unroll
    for (int j = 0; j < 8; ++j) { v[j] = xr[64 * j]; s += (v[j].x * v[j].x + v[j].y * v[j].y) + (v[j].z * v[j].z + v[j].w * v[j].w); }
    const float rstd = 1.0f / sqrtf(wave_sum(s) * (1.f / DM) + EPS);
    GAS unsigned long long* o8 = (GAS unsigned long long*)orow + lane;
#pragma unroll
    for (int j = 0; j < 8; ++j) o8[64 * j] = (unsigned long long)pk2(v[j].x, v[j].y) | ((unsigned long long)pk2(v[j].z, v[j].w) << 32);
    if (lane == 0) *rstd_out = rstd;
}

__constant__ double ROPE_REV[16] = {0.15915494309189535, 0.0700865215877985, 0.03086376340470123, 0.013591370636193905, 0.005985185712713705, 0.002635675898667414,
    0.001160663641240061, 0.0005111175045375439, 0.00022507907903927653, 9.911730936901935e-05, 4.364795279280289e-05, 1.9221100684944863e-05,
    8.464330808241401e-06, 3.727408601915352e-06, 1.6414262627950345e-06, 7.228293068832865e-07};

namespace att {
typedef short s16x4 __attribute__((ext_vector_type(4)));
typedef float f32x16 __attribute__((ext_vector_type(16)));
typedef unsigned u32x4 __attribute__((ext_vector_type(4)));
#define KSWZ(row, colB) ((row) * 256 + ((colB) ^ (((row) & 7) << 4)))
__device__ __forceinline__ int crow(int r, int hi) { return (r & 3) + 8 * (r >> 2) + 4 * hi; }
__device__ __forceinline__ int v_st(int k, int c) { const int kk = (k & ~0xC) | ((k & 4) << 1) | ((k & 8) >> 1); return ((kk >> 3) * 4 + (c >> 5)) * 512 + ((kk & 7) * 32 + (c & 31)) * 2; }
__device__ __forceinline__ int v_rd_base(int lane) { return ((lane & 3) << 3) | (((lane >> 2) & 3) << 6) | (((lane >> 4) & 1) << 5) | (((lane >> 5) & 1) << 8); }
constexpr int v_rd_off(int d0, int ks, int half) { return d0 * 512 + ks * 4096 + half * 2048; }
template <int OFF> __device__ __forceinline__ s16x4 tr_read(int vb) {
    s16x4 r; asm volatile("ds_read_b64_tr_b16 %0, %1 offset:%2" : "=&v"(r) : "v"(vb), "i"(OFF) : "memory"); return r;
}
template <int D0> __device__ __forceinline__ void pv_one(f32x16& od, int vb, bf16x8 pa0, bf16x8 pa1, bf16x8 pa2, bf16x8 pa3) {
    const s16x4 l0 = tr_read<v_rd_off(D0, 0, 0)>(vb), h0 = tr_read<v_rd_off(D0, 0, 1)>(vb), l1 = tr_read<v_rd_off(D0, 1, 0)>(vb), h1 = tr_read<v_rd_off(D0, 1, 1)>(vb);
    const s16x4 l2 = tr_read<v_rd_off(D0, 2, 0)>(vb), h2 = tr_read<v_rd_off(D0, 2, 1)>(vb), l3 = tr_read<v_rd_off(D0, 3, 0)>(vb), h3 = tr_read<v_rd_off(D0, 3, 1)>(vb);
    asm volatile("s_waitcnt lgkmcnt(0)" ::: "memory"); __builtin_amdgcn_sched_barrier(0);
#define PKV(L, H) (bf16x8){L[0], L[1], L[2], L[3], H[0], H[1], H[2], H[3]}
    od = __builtin_amdgcn_mfma_f32_32x32x16_bf16(pa0, PKV(l0, h0), od, 0, 0, 0);
    od = __builtin_amdgcn_mfma_f32_32x32x16_bf16(pa1, PKV(l1, h1), od, 0, 0, 0);
    od = __builtin_amdgcn_mfma_f32_32x32x16_bf16(pa2, PKV(l2, h2), od, 0, 0, 0);
    od = __builtin_amdgcn_mfma_f32_32x32x16_bf16(pa3, PKV(l3, h3), od, 0, 0, 0);
#undef PKV
}
struct Params {
    const bf16* q; bf16* o; int ldq; int active;
    const bf16 *k0, *v0; int ld0, n0;
    const bf16 *k1, *v1; int ld1, nv1;
    int ntile, tlo, thi;
    float m0, l0;
    int bias, tboff, i0;
};
__device__ __forceinline__ void unit(LAS unsigned char* lds, const Params& P, LAS float* tab, const float* tabsrc, const int wid) {
    const int lane = lane_id_opaque();
    const int tid = wid * 64 + lane, r32 = lane & 31, hi = lane >> 5;
    if (tabsrc != nullptr && tid < 257) tab[tid] = tabsrc[tid] * LOG2E;
    LAS float* wsf = (LAS float*)(lds + 65536 + wid * 256); LAS float* li_l = wsf; LAS float* al_l = wsf + 32;
    const int ldsbase = (int)(unsigned)(uintptr_t)lds;
    bf16x8 qr[8];
    if (P.active) {
        const bf16* Qw = P.q + (size_t)r32 * P.ldq + hi * 8;
#pragma unroll
        for (int d0 = 0; d0 < 8; ++d0) qr[d0] = *(const bf16x8*)(Qw + d0 * 16);
    } else {
#pragma unroll
        for (int d0 = 0; d0 < 8; ++d0) qr[d0] = (bf16x8){0, 0, 0, 0, 0, 0, 0, 0};
    }
    float m_reg = P.m0, l_reg = P.l0;
    f32x16 o[4];
#pragma unroll
    for (int d = 0; d < 4; ++d)
#pragma unroll
        for (int r = 0; r < 16; ++r) o[d][r] = 0.f;
    const int sr = tid >> 4, sc = (tid & 15) * 8;
    const int vst0 = v_st(sr, sc), vst1 = v_st(32 + sr, sc), kst0 = KSWZ(sr, sc * 2), kst1 = KSWZ(32 + sr, sc * 2);
    bf16x8 ks0, ks1, vs0, vs1;
    const bf16x8 zero8 = (bf16x8){0, 0, 0, 0, 0, 0, 0, 0};
#define ATT_LOAD(t) do { const bool s0 = (t) < P.n0; const bf16* kp = s0 ? P.k0 + (size_t)(t) * 64 * P.ld0 : P.k1; const bf16* vp = s0 ? P.v0 + (size_t)(t) * 64 * P.ld0 : P.v1; \
        const int ld = s0 ? P.ld0 : P.ld1, nv = s0 ? 64 : P.nv1; \
        ks0 = zero8; ks1 = zero8; vs0 = zero8; vs1 = zero8; \
        if (sr < nv) { ks0 = *(const bf16x8*)(kp + (size_t)sr * ld + sc); vs0 = *(const bf16x8*)(vp + (size_t)sr * ld + sc); } \
        if (32 + sr < nv) { ks1 = *(const bf16x8*)(kp + (size_t)(32 + sr) * ld + sc); vs1 = *(const bf16x8*)(vp + (size_t)(32 + sr) * ld + sc); } } while (0)
    const int NT = P.ntile;
    ATT_LOAD(0);
    for (int t = 0; t < NT; ++t) {
        const int buf = t & 1;
        asm volatile("s_waitcnt vmcnt(0)" ::: "memory");
        LAS unsigned char* Kb = lds + buf * 16384; LAS unsigned char* Vb = lds + 32768 + buf * 16384;
        *(LAS bf16x8*)(Kb + kst0) = ks0; *(LAS bf16x8*)(Kb + kst1) = ks1; *(LAS bf16x8*)(Vb + vst0) = vs0; *(LAS bf16x8*)(Vb + vst1) = vs1;
        if (t + 1 < NT) ATT_LOAD(t + 1);
        __syncthreads();
        if (P.active && t >= P.tlo && t <= P.thi) {
            f32x16 p0, p1;
#pragma unroll
            for (int r = 0; r < 16; ++r) { p0[r] = 0.f; p1[r] = 0.f; }
#pragma unroll
            for (int d0 = 0; d0 < 8; ++d0) { const int cb = (d0 * 16 + hi * 8) * 2;
                const bf16x8 b0 = *(const LAS bf16x8*)(Kb + KSWZ(r32, cb)); const bf16x8 b1 = *(const LAS bf16x8*)(Kb + KSWZ(32 + r32, cb));
                p0 = __builtin_amdgcn_mfma_f32_32x32x16_bf16(b0, qr[d0], p0, 0, 0, 0);
                p1 = __builtin_amdgcn_mfma_f32_32x32x16_bf16(b1, qr[d0], p1, 0, 0, 0); }
            constexpr float C = 0.088388347648318440f * LOG2E;
            if (P.bias) {
                const int tb = t - P.tboff;
                if (tb <= 5) { const float bc = tab[256];
#pragma unroll
                    for (int r = 0; r < 16; ++r) { p0[r] = fmaf(p0[r], C, bc); p1[r] = fmaf(p1[r], C, bc); } }
                else { const int base = 512 - 64 * tb + P.i0 + r32 + 128;
#pragma unroll
                    for (int r = 0; r < 16; ++r) { const int kk = crow(r, hi); int i0x = base - kk, i1x = base - kk - 32; i0x = i0x > 256 ? 256 : i0x; i1x = i1x > 256 ? 256 : i1x;
                        p0[r] = fmaf(p0[r], C, tab[i0x]); p1[r] = fmaf(p1[r], C, tab[i1x]); } }
            } else {
#pragma unroll
                for (int r = 0; r < 16; ++r) { p0[r] *= C; p1[r] *= C; }
            }
            const int nv = (t < P.n0) ? 64 : P.nv1;
            if (nv < 64) {
#pragma unroll
                for (int r = 0; r < 16; ++r) { const int kk = crow(r, hi); if (kk >= nv) p0[r] = -1e30f; if (kk + 32 >= nv) p1[r] = -1e30f; }
            }
            float pmax = p0[0];
#pragma unroll
            for (int r = 1; r < 16; ++r) pmax = fmaxf(pmax, p0[r]);
#pragma unroll
            for (int r = 0; r < 16; ++r) pmax = fmaxf(pmax, p1[r]);
            { auto rr = __builtin_amdgcn_permlane32_swap(__float_as_uint(pmax), __float_as_uint(pmax), false, false);
              pmax = fmaxf(__uint_as_float(rr[0]), __uint_as_float(rr[1])); }
            const float mn = fmaxf(m_reg, pmax); const float alpha = __builtin_amdgcn_exp2f(m_reg - mn); m_reg = mn;
            float ps = 0.f;
#pragma unroll
            for (int r = 0; r < 16; ++r) { p0[r] = __builtin_amdgcn_exp2f(p0[r] - mn); p1[r] = __builtin_amdgcn_exp2f(p1[r] - mn); ps += p0[r] + p1[r]; }
            { auto rr = __builtin_amdgcn_permlane32_swap(__float_as_uint(ps), __float_as_uint(ps), false, false);
              ps = __uint_as_float(rr[0]) + __uint_as_float(rr[1]); }
            l_reg = l_reg * alpha + ps;
            if (__any(alpha < 1.f)) { if (hi == 0) al_l[r32] = alpha; asm volatile("s_waitcnt lgkmcnt(0)" ::: "memory");
#pragma unroll
                for (int r = 0; r < 16; ++r) { const float a = al_l[crow(r, hi)];
#pragma unroll
                    for (int d = 0; d < 4; ++d) o[d][r] *= a; } }
            bf16x8 pa0, pa1, pa2, pa3;
#define PK4(P_, BASE, OUT) do { unsigned a0 = pk2(P_[BASE + 0], P_[BASE + 1]), a1 = pk2(P_[BASE + 2], P_[BASE + 3]);   \
    unsigned b0 = pk2(P_[BASE + 4], P_[BASE + 5]), b1 = pk2(P_[BASE + 6], P_[BASE + 7]);                              \
    auto r0 = __builtin_amdgcn_permlane32_swap(a0, b0, false, false); auto r1 = __builtin_amdgcn_permlane32_swap(a1, b1, false, false); \
    u32x4 w = {r0[0], r1[0], r0[1], r1[1]}; OUT = __builtin_bit_cast(bf16x8, w); } while (0)
            PK4(p0, 0, pa0); PK4(p0, 8, pa1); PK4(p1, 0, pa2); PK4(p1, 8, pa3);
#undef PK4
            const int vb = ldsbase + 32768 + buf * 16384 + v_rd_base(lane);
            pv_one<0>(o[0], vb, pa0, pa1, pa2, pa3); pv_one<1>(o[1], vb, pa0, pa1, pa2, pa3); pv_one<2>(o[2], vb, pa0, pa1, pa2, pa3); pv_one<3>(o[3], vb, pa0, pa1, pa2, pa3);
        }
    }
#undef ATT_LOAD
    if (P.active) {
        if (hi == 0) li_l[r32] = l_reg; asm volatile("s_waitcnt lgkmcnt(0)" ::: "memory");
#pragma unroll
        for (int r = 0; r < 16; ++r) { const int orow = crow(r, hi); const float rl = __builtin_amdgcn_rcpf(li_l[orow]);
            bf16* op = P.o + (size_t)orow * MIXW + r32;
#pragma unroll
            for (int d0 = 0; d0 < 4; ++d0) op[d0 * 32] = (bf16)(pk2(o[d0][r] * rl, 0.f) & 0xffffu); }
    }
    __syncthreads();
}
}

struct Args { const float* in[23]; float* out; unsigned char* ws; };
enum { I_XP = 0, I_XS, I_CAK, I_CAV, I_CBK, I_CBV, I_CMK, I_CMV, I_MEM, I_NFF1, I_WFF1I, I_WFF1O, I_NMIX, I_WIN, I_QKG, I_SINK, I_REL, I_NMEM, I_WMEM, I_WOUT, I_NFF2, I_WFF2I, I_WFF2O };

#define CAS __attribute__((address_space(4)))
__global__ void __launch_bounds__(NWAVES * 64, 2) enc_fwd(Args args) {
    extern __shared__ __attribute__((aligned(16))) unsigned char lds_raw[];
    LAS unsigned char* lds = (LAS unsigned char*)lds_raw;
    volatile LAS unsigned* MISC = (volatile LAS unsigned*)(lds + MISC_OFF);
    const int G0 = gridDim.x, bx0 = blockIdx.x, wave0 = __builtin_amdgcn_readfirstlane((int)threadIdx.x >> 6);
    unsigned char* const ws0 = args.ws; float* const out0 = args.out;
    const float* const CAS* const ain0 = (const float* const CAS*)__builtin_amdgcn_kernarg_segment_ptr();
#define PHASE_IDS() \
    const int lane = lane_id_opaque(); \
    int G = G0, bx = bx0, wave = wave0; unsigned long long ws_i = (unsigned long long)ws0, out_i = (unsigned long long)out0; const float* const CAS* ain = ain0; \
    asm volatile("" : "+s"(G), "+s"(bx), "+s"(wave), "+s"(ws_i), "+s"(out_i), "+s"(ain)); \
    unsigned char* const ws = (unsigned char*)(GAS unsigned char*)ws_i; float* const out = (float*)(GAS float*)out_i;     \
    const int tid = wave * 64 + lane, vcu = (G % 8 == 0) ? (bx % 8) * (G / 8) + bx / 8 : bx, NGW = G * NWAVES, gw = vcu * NWAVES + wave; \
    (void)tid; (void)gw; (void)NGW; (void)out; (void)ain; (void)ws
#define WSP(off) ((bf16*)(ws + (off)))
#define AIN(i) ((const float*)(const GAS float*)ain[i])
    for (int u = threadIdx.x; u < (LDS_BYTES - LDSCTL_OFF) / 4; u += NWAVES * 64) ((LAS unsigned*)(lds + LDSCTL_OFF))[u] = 0u;
    __syncthreads();
    XcdBarrier bar = xcd_barrier_post((unsigned*)(ws0 + WS_CTL) + CW_BAR, MISC + 8);
#define GRID_BAR() xcd_barrier(bar)

    {
        PHASE_IDS();
        LAS float* scr = (LAS float*)(lds + wave * 16384);
        constexpr int IT_A = (DM / 64) * (2 * DFF / 32), IT_B = (DFF / 64) * (DM / 32), IT_IN = (DM / 64) * (INC / 32), IT_OUT = (MIXW / 64) * (DM / 32), IT_MEM = (DM / 64) * (1024 / 32);
        constexpr int IT_L = 2 * IT_A + 2 * IT_B + IT_IN + IT_OUT + IT_MEM;
        for (int it = gw; it < DEPTH * IT_L; it += NGW) {
            const int l = it / IT_L; int r = it % IT_L;
            unsigned char* lw = ws + WS_W + (size_t)l * LW_END;
            if (r < 2 * IT_A) {
                const int f = r / IT_A; r -= f * IT_A;
                const float* W = (f ? AIN(I_WFF2I) : AIN(I_WFF1I)) + (size_t)l * DM * 2 * DFF; bf16* WT = (bf16*)(lw + (f ? LW_W2A : LW_W1A));
                const int nblk = 2 * DFF / 32, kb = r / nblk, nb = r % nblk, nd = nb * 32;
                const int ns = ((nd & 255) >> 7) * DFF + (nd >> 8) * 128 + (nd & 127);
                tr_item(W, 2 * DFF, DM, WT, kb * 64, ns, nd, (f ? AIN(I_NFF2) : AIN(I_NFF1)) + (size_t)l * DM, scr, lane); continue; }
            r -= 2 * IT_A;
            if (r < 2 * IT_B) {
                const int f = r / IT_B; r -= f * IT_B;
                const float* W = (f ? AIN(I_WFF2O) : AIN(I_WFF1O)) + (size_t)l * DFF * DM; bf16* WT = (bf16*)(lw + (f ? LW_W2B : LW_W1B));
                const int nblk = DM / 32, kb = r / nblk, nb = r % nblk;
                tr_item(W, DM, DFF, WT, kb * 64, nb * 32, nb * 32, nullptr, scr, lane); continue; }
            r -= 2 * IT_B;
            if (r < IT_IN) { const float* W = AIN(I_WIN) + (size_t)l * DM * INC; bf16* WT = (bf16*)(lw + LW_WIN);
                const int nblk = INC / 32, kb = r / nblk, nb = r % nblk;
                tr_item(W, INC, DM, WT, kb * 64, nb * 32, nb * 32, AIN(I_NMIX) + (size_t)l * DM, scr, lane); continue; }
            r -= IT_IN;
            if (r < IT_OUT) { const float* W = AIN(I_WOUT) + (size_t)l * MIXW * DM; bf16* WT = (bf16*)(lw + LW_WOUT);
                const int nblk = DM / 32, kb = r / nblk, nb = r % nblk;
                tr_item(W, DM, MIXW, WT, kb * 64, nb * 32, nb * 32, nullptr, scr, lane); continue; }
            r -= IT_OUT;
            { const float* W = AIN(I_WMEM) + (size_t)l * DM * 1024; bf16* WT = WSP(WS_WMEM) + (size_t)l * 1024 * DM;
                const int nblk = 1024 / 32, kb = r / nblk, nb = r % nblk;
                tr_item(W, 1024, DM, WT, kb * 64, nb * 32, nb * 32, AIN(I_NMEM) + (size_t)l * DM, scr, lane); }
        }
        {
            const size_t gt = (size_t)gw * 64 + lane, GT = (size_t)NGW * 64;
#define CVT_CACHE(IDX, NEL, OFF) do { const float* src = AIN(IDX); bf16* dst = WSP(OFF); \
                for (size_t i = gt; i < (NEL) / 8; i += GT) { const f32x4 a = *(const GAS f32x4*)(src + i * 8), b = *(const GAS f32x4*)(src + i * 8 + 4); \
                    v4u w; w.x = pk2(a.x, a.y); w.y = pk2(a.z, a.w); w.z = pk2(b.x, b.y); w.w = pk2(b.z, b.w); *(GAS v4u*)(dst + i * 8) = w; } } while (0)
            CVT_CACHE(I_CAK, N_CA, WS_CAK); CVT_CACHE(I_CAV, N_CA, WS_CAV); CVT_CACHE(I_CBK, N_CB, WS_CBK); CVT_CACHE(I_CBV, N_CB, WS_CBV); CVT_CACHE(I_CMK, N_CM, WS_CMK); CVT_CACHE(I_CMV, N_CM, WS_CMV);
#undef CVT_CACHE
        }
        for (int m = gw; m < MMEM; m += NGW) rms_row_to_bf16(AIN(I_MEM) + (size_t)m * DM, nullptr, WSP(WS_AMEM) + (size_t)m * DM, lane);
        for (int m = gw; m < MT; m += NGW) { const float* xr = (m < MP) ? AIN(I_XP) + (size_t)m * DM : AIN(I_XS) + (size_t)(m - MP) * DM;
            row_to_bf16_rstd(xr, WSP(WS_H) + (size_t)m * DM, (float*)(ws + WS_RSTD) + m, lane); }
    }
    GRID_BAR();
    {
        PHASE_IDS();
        pg8::Gemm g{WSP(WS_AMEM), WSP(WS_WMEM), MMEM, DEPTH * 1024, DM}; pg8::StaticOrder S; S.init(MMEM, DEPTH * 1024, DM, G, bx);
        EpiMem E{out + O_MKP};
        pg8::gemm_phase<EpiMem, pg8::StaticOrder, true, true>(lds, g, S, E, wave);
    }
    GRID_BAR();
    { PHASE_IDS();
    for (int it = gw; it < DEPTH * MMEM; it += NGW) {
        const int l = it / MMEM; const size_t off = (size_t)it * 512 + lane * 8;
        const float* gk = AIN(I_QKG) + ((size_t)l * 6 + 5) * HD + (lane & 15) * 8;
        float* kp = out + O_MKP + off; const float* vp = out + O_MVP + off;
        f32x4 a = *(const GAS f32x4*)kp, b = *(const GAS f32x4*)(kp + 4);
        float ss = (a.x * a.x + a.y * a.y) + (a.z * a.z + a.w * a.w) + (b.x * b.x + b.y * b.y) + (b.z * b.z + b.w * b.w);
        const float rstd = 1.0f / sqrtf(sum16(ss) * (1.f / HD) + EPS);
        const f32x4 g0 = *(const GAS f32x4*)gk, g1 = *(const GAS f32x4*)(gk + 4);
        a = a * rstd * g0; b = b * rstd * g1;
        *(GAS f32x4*)kp = a; *(GAS f32x4*)(kp + 4) = b;
        v4u w; w.x = pk2(a.x, a.y); w.y = pk2(a.z, a.w); w.z = pk2(b.x, b.y); w.w = pk2(b.z, b.w); *(GAS v4u*)(WSP(WS_MKB) + off) = w;
        const f32x4 c = *(const GAS f32x4*)vp, d = *(const GAS f32x4*)(vp + 4);
        w.x = pk2(c.x, c.y); w.y = pk2(c.z, c.w); w.z = pk2(d.x, d.y); w.w = pk2(d.z, d.w); *(GAS v4u*)(WSP(WS_MVB) + off) = w;
    } }

#define MINI_PHASE(XS_SRC, NKC, SCALE) do { PHASE_IDS(); \
        LAS float* red = (LAS float*)lds; const float* px = (const float*)(ws + WS_PARTX); float* rstd = (float*)(ws + WS_RSTD); \
        for (int r = bx; r < MS; r += G) { const int col = wave * 256 + lane * 4; \
            f32x4 v = *(const GAS f32x4*)((XS_SRC) + (size_t)r * DM + col); f32x4 sacc = (f32x4){0.f, 0.f, 0.f, 0.f}; \
            for (int kc = 0; kc < (NKC); ++kc) sacc += *(const GAS f32x4*)(px + ((size_t)kc * MS + r) * DM + col); \
            v += sacc * (SCALE); \
            *(GAS f32x4*)(out + O_YS + (size_t)r * DM + col) = v; \
            *(GAS unsigned long long*)(WSP(WS_H) + (size_t)(MP + r) * DM + col) = (unsigned long long)pk2(v.x, v.y) | ((unsigned long long)pk2(v.z, v.w) << 32); \
            const float ss = wave_sum((v.x * v.x + v.y * v.y) + (v.z * v.z + v.w * v.w)); \
            if (lane == 0) red[wave] = ss; \
            __syncthreads(); \
            if (tid == 0) { float t = 0.f; for (int w = 0; w < NWAVES; ++w) t += red[w]; rstd[MP + r] = 1.0f / sqrtf(t * (1.f / DM) + EPS); } \
            __syncthreads(); } \
        const float* part = (const float*)(ws + WS_PART); \
        for (int row = gw * 64 + lane; row < MP; row += NGW * 64) { const GAS f32x4* p = (const GAS f32x4*)(part + (size_t)row * 32); f32x4 t = p[0]; \
            _Pragma("unroll") for (int j = 1; j < 8; ++j) t += p[j]; \
            rstd[row] = 1.0f / sqrtf(((t.x + t.y) + (t.z + t.w)) * (1.f / DM) + EPS); } } while (0)
#define FFN_BLOCK(LW_A, LW_B, RES_P, RES_S) do { \
        { PHASE_IDS(); \
          pg8::Gemm g{WSP(WS_H), WSP(WS_W + (size_t)l * LW_END + (LW_A)), MT, 2 * DFF, DM}; pg8::StaticOrder S; S.init(MT, 2 * DFF, DM, G, bx); \
          EpiSwiGLU E{WSP(WS_HID), (const float*)(ws + WS_RSTD)}; \
          pg8::gemm_phase<EpiSwiGLU, pg8::StaticOrder, true, true>(lds, g, S, E, wave); } \
        GRID_BAR(); \
        { PHASE_IDS(); \
          pg8::Gemm g{WSP(WS_HID), WSP(WS_W + (size_t)l * LW_END + (LW_B)), MP, DM, DFF}; pg8::StaticOrder S; S.init(MP, DM, DFF, G, bx); \
          EpiResidP E{(RES_P), out, WSP(WS_H), (float*)(ws + WS_PART), 0.5f}; \
          pg8::gemm_phase<EpiResidP, pg8::StaticOrder, true, true>(lds, g, S, E, wave); } \
        { PHASE_IDS(); \
          pg8::Gemm g{WSP(WS_HID), WSP(WS_W + (size_t)l * LW_END + (LW_B)), MT, DM, DFF}; pg8::SplitOrder S{8 * NKC_FF, bx, NKC_FF, TPC, DFF / 64, MP / 256}; \
          EpiPartial E{(float*)(ws + WS_PARTX)}; \
          pg8::gemm_phase<EpiPartial, pg8::SplitOrder, true, true>(lds, g, S, E, wave); } \
        GRID_BAR(); \
        MINI_PHASE((RES_S), NKC_FF, 0.5f); } while (0)

    for (int l = 0; l < DEPTH; ++l) {
        FFN_BLOCK(LW_W1A, LW_W1B, (l == 0 ? AIN(I_XP) : (const float*)out), (l == 0 ? AIN(I_XS) : (const float*)(out + O_YS)));
        GRID_BAR();
        {
            PHASE_IDS();
            pg8::Gemm g{WSP(WS_H), WSP(WS_W + (size_t)l * LW_END + LW_WIN), MT, INC, DM}; pg8::StaticOrder S; S.init(MT, INC, DM, G, bx);
            EpiProj E{WSP(WS_PROJ), (const float*)(ws + WS_RSTD)};
            pg8::gemm_phase<EpiProj, pg8::StaticOrder, true, true>(lds, g, S, E, wave);
        }
        GRID_BAR();
        {
            PHASE_IDS();
            bf16* PROJ = WSP(WS_PROJ);
            const int li = lane & 15, grp = lane >> 4;
            const float* qkg = AIN(I_QKG) + (size_t)l * 6 * HD + li * 8;
            for (int row = gw; row < MT; row += NGW) {
                bf16* pr = PROJ + (size_t)row * INC;
                int b, t, pos; const bool isP = row < MP;
                if (isP) { b = row >> 12; t = row & 4095; pos = t; } else { const int s = row - MP; b = s >> 5; t = s & 31; pos = PAST + t; }
                float cs[8], sn[8];
#pragma unroll
                for (int j = 0; j < 8; ++j) { const double rev = (double)pos * ROPE_REV[8 * (li & 1) + j]; const float fr = (float)(rev - floor(rev));
                    cs[j] = __builtin_amdgcn_cosf(fr); sn[j] = __builtin_amdgcn_sinf(fr); }
#pragma unroll
                for (int s = 0; s < 7; ++s) {
                    const v4u raw = *(const GAS v4u*)(pr + s * 512 + lane * 8);
                    float x[8] = {bf_lo(raw.x), bf_hi(raw.x), bf_lo(raw.y), bf_hi(raw.y), bf_lo(raw.z), bf_hi(raw.z), bf_lo(raw.w), bf_hi(raw.w)};
                    const bool isv = (s == 5) || (s == 2 && grp >= 2);
                    const int gi = (s < 2) ? 0 : (s == 2) ? 1 : (s == 3) ? 2 : (s == 4) ? 3 : 4;
                    const bool rope = (s < 2) || (s == 2 && grp < 2);
                    if (s != 5) {
                        float ss = 0.f;
#pragma unroll
                        for (int j = 0; j < 8; ++j) ss += x[j] * x[j];
                        const float rstd = 1.0f / sqrtf(sum16(ss) * (1.f / HD) + EPS);
                        const f32x4 g0 = *(const GAS f32x4*)(qkg + gi * HD), g1 = *(const GAS f32x4*)(qkg + gi * HD + 4);
                        const float gg[8] = {g0.x, g0.y, g0.z, g0.w, g1.x, g1.y, g1.z, g1.w};
                        float y[8];
#pragma unroll
                        for (int j = 0; j < 8; ++j) y[j] = x[j] * rstd * gg[j];
                        if (s <= 2) {
#pragma unroll
                            for (int j = 0; j < 8; ++j) { const float oth = swz_xor<2>(y[j]);
                                const float rot = (li < 2) ? (y[j] * cs[j] - oth * sn[j]) : (y[j] * cs[j] + oth * sn[j]);
                                if (rope && li < 4) y[j] = rot; }
                        }
#pragma unroll
                        for (int j = 0; j < 8; ++j) x[j] = isv ? x[j] : y[j];
                        v4u w; w.x = pk2(x[0], x[1]); w.y = pk2(x[2], x[3]); w.z = pk2(x[4], x[5]); w.w = pk2(x[6], x[7]);
                        if (!isv) *(GAS v4u*)(pr + s * 512 + lane * 8) = w;
                    }
                    if (s == 2 || s == 4 || s == 5) {
                        float* dst = nullptr;
                        if (s == 2) { const int gh = grp & 1; const bool v = grp >= 2;
                            if (isP) { if (t >= SEQ - 128) dst = out + (v ? O_AVP : O_AKP) + ((((size_t)l * NBATCH + b) * 128 + (t - (SEQ - 128))) * 2 + gh) * HD; }
                            else dst = out + (v ? O_AVS : O_AKS) + ((((size_t)l * SBATCH + b) * SSEQ + t) * 2 + gh) * HD;
                        } else { const bool v = (s == 5);
                            if (isP) { if (t >= SEQ - 512) dst = out + (v ? O_BVP : O_BKP) + ((((size_t)l * NBATCH + b) * 512 + (t - (SEQ - 512))) * 4 + grp) * HD; }
                            else dst = out + (v ? O_BVS : O_BKS) + ((((size_t)l * SBATCH + b) * SSEQ + t) * 4 + grp) * HD;
                        }
                        if (dst) { dst += li * 8; *(GAS f32x4*)dst = (f32x4){x[0], x[1], x[2], x[3]}; *(GAS f32x4*)(dst + 4) = (f32x4){x[4], x[5], x[6], x[7]}; }
                    }
                }
            }
        }
        GRID_BAR();
        {
            PHASE_IDS();
            LAS float* tab = (LAS float*)(lds + 69632);
            bf16* PROJ = WSP(WS_PROJ); bf16* OB = WSP(WS_OB);
            constexpr int NUNITS = 512 + 512 + 1024 + 32 + 32 + 16;
            for (int u = bx; u < NUNITS; u += G) {
                att::Params P; P.ldq = INC; P.active = 1; P.k1 = nullptr; P.v1 = nullptr; P.ld1 = INC; P.nv1 = 64; P.m0 = -1e30f; P.l0 = 0.f; P.bias = 0; P.tboff = 0; P.i0 = 0;
                int bias_h = -1;
                if (u < 512) {
                    const int b = u >> 6, h = (u >> 4) & 3, c0 = (u & 15) * 4, cw = c0 + (wave >> 1), i0 = (wave & 1) * 32;
                    const size_t rowq = (size_t)b * SEQ + cw * 64 + i0;
                    P.q = PROJ + rowq * INC + C_QB + h * HD; P.o = OB + rowq * MIXW + (8 + h) * HD;
                    const int cfirst = c0 - 8 > 0 ? c0 - 8 : 0; P.ntile = c0 + 4 - cfirst; P.n0 = P.ntile;
                    P.k0 = PROJ + ((size_t)b * SEQ + cfirst * 64) * INC + C_KB + h * HD; P.v0 = PROJ + ((size_t)b * SEQ + cfirst * 64) * INC + C_VB + h * HD; P.ld0 = INC;
                    P.tboff = cw - 8 - cfirst; P.tlo = P.tboff > 0 ? P.tboff : 0; P.thi = cw - cfirst; P.bias = 1; P.i0 = i0; bias_h = h;
                } else if (u < 1024) {
                    const int v = u - 512, b = v >> 6, h = (v >> 4) & 3, qb = v & 15;
                    const size_t rowq = (size_t)b * SEQ + qb * 256 + wave * 32;
                    P.q = PROJ + rowq * INC + C_QM + h * HD; P.o = OB + rowq * MIXW + (12 + h) * HD;
                    P.ntile = 4; P.n0 = 4; P.k0 = WSP(WS_MKB) + ((size_t)l * MMEM + b * NMEM) * 512 + h * HD; P.v0 = WSP(WS_MVB) + ((size_t)l * MMEM + b * NMEM) * 512 + h * HD; P.ld0 = 512;
                    P.tlo = 0; P.thi = 3;
                } else if (u < 2048) {
                    const int v = u - 1024, b = v >> 7, c = (v >> 1) & 63, g = v & 1, hq = 4 * g + (wave >> 1), i0 = (wave & 1) * 32;
                    const size_t rowq = (size_t)b * SEQ + c * 64 + i0;
                    P.q = PROJ + rowq * INC + C_QA + hq * HD; P.o = OB + rowq * MIXW + hq * HD;
                    const int cfirst = c - 2 > 0 ? c - 2 : 0; P.ntile = c - cfirst + 1; P.n0 = P.ntile;
                    P.k0 = PROJ + ((size_t)b * SEQ + cfirst * 64) * INC + C_KA + g * HD; P.v0 = PROJ + ((size_t)b * SEQ + cfirst * 64) * INC + C_VA + g * HD; P.ld0 = INC;
                    P.tlo = 0; P.thi = P.ntile - 1; P.m0 = AIN(I_SINK)[l * 8 + hq] * LOG2E; P.l0 = 1.f;
                } else if (u < 2080) {
                    const int v = u - 2048, b = v >> 2, h = v & 3; const size_t rowq = (size_t)MP + b * SSEQ;
                    P.q = PROJ + rowq * INC + C_QB + h * HD; P.o = OB + rowq * MIXW + (8 + h) * HD; P.active = (wave == 0);
                    P.ntile = 9; P.n0 = 8; P.k0 = WSP(WS_CBK) + (((size_t)l * SBATCH + b) * 512) * 512 + h * HD; P.v0 = WSP(WS_CBV) + (((size_t)l * SBATCH + b) * 512) * 512 + h * HD; P.ld0 = 512;
                    P.k1 = PROJ + rowq * INC + C_KB + h * HD; P.v1 = PROJ + rowq * INC + C_VB + h * HD; P.nv1 = SSEQ;
                    P.tlo = 0; P.thi = 8; P.bias = 1; bias_h = h;
                } else if (u < 2112) {
                    const int v = u - 2080, b = v >> 2, h = v & 3; const size_t rowq = (size_t)MP + b * SSEQ;
                    P.q = PROJ + rowq * INC + C_QM + h * HD; P.o = OB + rowq * MIXW + (12 + h) * HD; P.active = (wave == 0);
                    P.ntile = 4; P.n0 = 4; P.k0 = WSP(WS_CMK) + (((size_t)l * SBATCH + b) * NMEM) * 512 + h * HD; P.v0 = WSP(WS_CMV) + (((size_t)l * SBATCH + b) * NMEM) * 512 + h * HD; P.ld0 = 512;
                    P.tlo = 0; P.thi = 3;
                } else {
                    const int v = u - 2112, b = v >> 1, g = v & 1, hq = 4 * g + (wave >> 1); const size_t rowq = (size_t)MP + b * SSEQ;
                    P.q = PROJ + rowq * INC + C_QA + hq * HD; P.o = OB + rowq * MIXW + hq * HD; P.active = ((wave & 1) == 0);
                    P.ntile = 3; P.n0 = 2; P.k0 = WSP(WS_CAK) + (((size_t)l * SBATCH + b) * 128) * 256 + g * HD; P.v0 = WSP(WS_CAV) + (((size_t)l * SBATCH + b) * 128) * 256 + g * HD; P.ld0 = 256;
                    P.k1 = PROJ + rowq * INC + C_KA + g * HD; P.v1 = PROJ + rowq * INC + C_VA + g * HD; P.nv1 = SSEQ;
                    P.tlo = 0; P.thi = 2; P.m0 = AIN(I_SINK)[l * 8 + hq] * LOG2E; P.l0 = 1.f;
                }
                att::unit(lds, P, tab, bias_h >= 0 ? AIN(I_REL) + ((size_t)l * 4 + bias_h) * 257 : nullptr, wave);
            }
        }
        GRID_BAR();
        {
            PHASE_IDS();
            pg8::Gemm g{WSP(WS_OB), WSP(WS_W + (size_t)l * LW_END + LW_WOUT), MP, DM, MIXW}; pg8::StaticOrder S; S.init(MP, DM, MIXW, G, bx);
            EpiResidP E{out, out, WSP(WS_H), (float*)(ws + WS_PART), 1.0f};
            pg8::gemm_phase<EpiResidP, pg8::StaticOrder, true, true>(lds, g, S, E, wave);
        }
        {
            PHASE_IDS();
            pg8::Gemm g{WSP(WS_OB), WSP(WS_W + (size_t)l * LW_END + LW_WOUT), MT, DM, MIXW}; pg8::SplitOrder S{8 * NKC_OUT, bx, NKC_OUT, TPC, MIXW / 64, MP / 256};
            EpiPartial E{(float*)(ws + WS_PARTX)};
            pg8::gemm_phase<EpiPartial, pg8::SplitOrder, true, true>(lds, g, S, E, wave);
        }
        GRID_BAR();
        MINI_PHASE((const float*)(out + O_YS), NKC_OUT, 1.0f);
        GRID_BAR();
        FFN_BLOCK(LW_W2A, LW_W2B, (const float*)out, (const float*)(out + O_YS));
        if (l + 1 < DEPTH) GRID_BAR();
    }
}

extern "C" void kernel_launch(void* const* d_in, const int* in_sizes, int n_in, void* d_out, int out_size, void* d_ws, size_t ws_size, hipStream_t stream) {
    static int grid = 0;
    if (grid == 0) {
        if (n_in != 23 || (size_t)out_size != O_END || ws_size < WS_END) { fprintf(stderr, "kernel_launch: unexpected shapes (n_in %d out %d ws %zu)\n", n_in, out_size, ws_size); grid = -1; return; }
        int dev = 0, cus = 0;
        if (hipGetDevice(&dev) != hipSuccess || hipDeviceGetAttribute(&cus, hipDeviceAttributeMultiprocessorCount, dev) != hipSuccess) { grid = -1; return; }
        if (hipFuncSetAttribute((const void*)enc_fwd, hipFuncAttributeMaxDynamicSharedMemorySize, LDS_BYTES) != hipSuccess) { fprintf(stderr, "kernel_launch: hipFuncSetAttribute failed\n"); grid = -1; return; }
        int per_cu = 0;
        if (hipOccupancyMaxActiveBlocksPerMultiprocessor(&per_cu, (const void*)enc_fwd, NWAVES * 64, LDS_BYTES) != hipSuccess || per_cu < 1) fprintf(stderr, "kernel_launch: occupancy query reports %d\n", per_cu);
        (void)hipGetLastError();
        grid = cus;
    }
    if (grid < 0) return;
    if (hipMemsetAsync((char*)d_ws + WS_CTL, 0, CTL_ZERO_BYTES, stream) != hipSuccess) return;
    Args a{};
    for (int i = 0; i < 23; ++i) a.in[i] = (const float*)d_in[i];
    a.out = (float*)d_out; a.ws = (unsigned char*)d_ws;
    hipLaunchKernelGGL(enc_fwd, dim3(grid), dim3(NWAVES * 64), LDS_BYTES, stream, a);
}
```
